# Optimizing an MI355X kernel written in HIP

```python
import jax, jax.numpy as jnp
from jax import lax
import numpy as np

D_MODEL = 1024
BATCH = 1
SEQ = 16384
DEPTH = 4
DEC_BATCH = 8
DEC_SEQ = 16
PAST_LEN = 1024

CHUNK = 64
D_A = 256
HEADS_A = 4
D_B = 512
HEADS_B = 8
HEAD_DIM_B = D_B // HEADS_B
D_C = 256
HEADS_C = 4
D_MIX = D_A + D_B + D_C
D_IN = 3 * D_A + 2 * D_B + 2 * D_C
CONV_A = 3
CONV_B = 4
CONV_C = 31
RG_C = 8.0
D_FF = 2816
N_SUB = 3
EPS = 1e-6

kernel_name = 'hybrid_streaming_encoder_step'


def rmsnorm(x, g):
    xf = x.astype(jnp.float32)
    y = xf * lax.rsqrt(jnp.mean(xf * xf, axis=-1, keepdims=True) + EPS)
    return (y * g.astype(jnp.float32)).astype(x.dtype)


def layernorm(x, g, b):
    xf = x.astype(jnp.float32)
    mu = jnp.mean(xf, axis=-1, keepdims=True)
    var = jnp.mean(jnp.square(xf - mu), axis=-1, keepdims=True)
    y = (xf - mu) * lax.rsqrt(var + EPS)
    return (y * g.astype(jnp.float32) + b.astype(jnp.float32)).astype(x.dtype)


def causal_dwconv(u, buf, w):
    k = w.shape[0]
    xp = jnp.concatenate([buf.astype(u.dtype), u], axis=1)
    y = lax.conv_general_dilated(xp, w[:, None, :].astype(u.dtype), window_strides=(1,),
                                 padding='VALID', dimension_numbers=('NWC', 'WIO', 'NWC'),
                                 feature_group_count=u.shape[-1])
    return y, xp[:, xp.shape[1] - (k - 1):]


def swiglu(h, w1, w3, w2):
    return (jax.nn.silu(h @ w1) * (h @ w3)) @ w2


def _lin_combine(left, right):
    a_l, b_l = left
    a_r, b_r = right
    return a_l * a_r, a_r * b_l + b_r


def rglru(xb, h0, w_r, b_r, w_i, b_i, lam):
    bsz, t, _ = xb.shape
    xh = xb.reshape(bsz, t, HEADS_B, HEAD_DIM_B)
    r = jax.nn.sigmoid((jnp.einsum('bthi,hij->bthj', xh, w_r).reshape(bsz, t, D_B) + b_r).astype(jnp.float32))
    i = jax.nn.sigmoid((jnp.einsum('bthi,hij->bthj', xh, w_i).reshape(bsz, t, D_B) + b_i).astype(jnp.float32))
    log_a = RG_C * r * jax.nn.log_sigmoid(lam.astype(jnp.float32))
    a = jnp.exp(log_a)
    bterm = jnp.sqrt(-jnp.expm1(2.0 * log_a)) * i * xb.astype(jnp.float32)
    bterm = bterm.at[:, 0].add(a[:, 0] * h0.astype(jnp.float32))
    _, h = lax.associative_scan(_lin_combine, (a, bterm), axis=1)
    return h.astype(xb.dtype), h[:, -1].astype(h0.dtype)


def token_mixer(h, st_a, st_b, st_h, st_c, w_in, w_out, w_conv_a, w_conv_b, b_conv_b,
                w_gate_r, b_gate_r, w_gate_i, b_gate_i, rg_lambda, w_conv_c, b_conv_c,
                ln_c_g, ln_c_b, grp_g):
    u = h @ w_in
    splits = [D_A, 2 * D_A, 3 * D_A, 3 * D_A + D_B, 3 * D_A + 2 * D_B, 3 * D_A + 2 * D_B + D_C]
    a_b, a_c, a_x, b_x, b_g, c_v, c_g = jnp.split(u, splits, axis=-1)
    ya, new_a = causal_dwconv(a_c * a_x, st_a, w_conv_a)
    ya = a_b * ya
    xb, new_b = causal_dwconv(b_x, st_b, w_conv_b)
    yb, new_h = rglru(xb + b_conv_b, st_h, w_gate_r, b_gate_r, w_gate_i, b_gate_i, rg_lambda)
    yb = yb * jax.nn.gelu(b_g)
    v = c_v * jax.nn.sigmoid(c_g)
    yc, new_c = causal_dwconv(v, st_c, w_conv_c)
    yc = jax.nn.silu(layernorm(yc + b_conv_c, ln_c_g, ln_c_b))
    y = jnp.concatenate([rmsnorm(ya, grp_g[:D_A]),
                         rmsnorm(yb, grp_g[D_A:D_A + D_B]),
                         rmsnorm(yc, grp_g[D_A + D_B:])], axis=-1)
    return y @ w_out, new_a, new_b, new_h, new_c


def setup_inputs(seed: int = 0) -> dict:
    key = jax.random.key(seed)
    ks = jax.random.split(key, 40)
    f32 = jnp.float32

    def nrm(k, shape, scale):
        return jax.random.normal(k, shape, f32) * scale

    s = D_MODEL ** -0.5
    u_lam = jax.random.uniform(ks[21], (DEPTH, D_B), f32, 0.9, 0.999)
    return {
        'x_prompt': nrm(ks[0], (BATCH, SEQ, D_MODEL), 1.0),
        'x_sample': nrm(ks[1], (DEC_BATCH, DEC_SEQ, D_MODEL), 1.0),
        'state_conv_a': nrm(ks[2], (DEPTH, DEC_BATCH, CONV_A - 1, D_A), 1.0),
        'state_conv_b': nrm(ks[3], (DEPTH, DEC_BATCH, CONV_B - 1, D_B), 1.0),
        'state_rglru': nrm(ks[4], (DEPTH, DEC_BATCH, D_B), 0.5),
        'state_conv_c': nrm(ks[5], (DEPTH, DEC_BATCH, CONV_C - 1, D_C), 1.0),
        'c_prompt': nrm(ks[6], (BATCH, D_MODEL), 1.0),
        'c_sample': nrm(ks[7], (DEC_BATCH, D_MODEL), 1.0),
        'w_ada': nrm(ks[8], (DEPTH, D_MODEL, 3 * N_SUB * D_MODEL), s),
        'b_ada': nrm(ks[9], (DEPTH, 3 * N_SUB * D_MODEL), 0.02),
        'norm_pre': 1.0 + nrm(ks[10], (DEPTH, N_SUB, D_MODEL), 0.02),
        'norm_post': 1.0 + nrm(ks[11], (DEPTH, N_SUB, D_MODEL), 0.02),
        'ffn_w1': nrm(ks[12], (DEPTH, 2, D_MODEL, D_FF), s),
        'ffn_w3': nrm(ks[13], (DEPTH, 2, D_MODEL, D_FF), s),
        'ffn_w2': nrm(ks[14], (DEPTH, 2, D_FF, D_MODEL), D_FF ** -0.5),
        'w_in': nrm(ks[15], (DEPTH, D_MODEL, D_IN), s),
        'w_out': nrm(ks[16], (DEPTH, D_MIX, D_MODEL), D_MIX ** -0.5),
        'w_conv_a': nrm(ks[17], (DEPTH, CONV_A, D_A), CONV_A ** -0.5),
        'w_conv_b': nrm(ks[18], (DEPTH, CONV_B, D_B), CONV_B ** -0.5),
        'b_conv_b': nrm(ks[19], (DEPTH, D_B), 0.02),
        'w_gate_r': nrm(ks[20], (DEPTH, HEADS_B, HEAD_DIM_B, HEAD_DIM_B), HEAD_DIM_B ** -0.5),
        'b_gate_r': nrm(ks[22], (DEPTH, D_B), 0.02),
        'w_gate_i': nrm(ks[23], (DEPTH, HEADS_B, HEAD_DIM_B, HEAD_DIM_B), HEAD_DIM_B ** -0.5),
        'b_gate_i': nrm(ks[24], (DEPTH, D_B), 0.02),
        'rg_lambda': jnp.log(u_lam) - jnp.log1p(-u_lam),
        'w_conv_c': nrm(ks[25], (DEPTH, CONV_C, D_C), CONV_C ** -0.5),
        'b_conv_c': nrm(ks[26], (DEPTH, D_C), 0.02),
        'ln_c_g': 1.0 + nrm(ks[27], (DEPTH, D_C), 0.02),
        'ln_c_b': nrm(ks[28], (DEPTH, D_C), 0.02),
        'grp_g': 1.0 + nrm(ks[29], (DEPTH, D_MIX), 0.02),
    }


def reference(x_prompt, x_sample, state_conv_a, state_conv_b, state_rglru, state_conv_c,
              c_prompt, c_sample, w_ada, b_ada, norm_pre, norm_post, ffn_w1, ffn_w3, ffn_w2,
              w_in, w_out, w_conv_a, w_conv_b, b_conv_b, w_gate_r, b_gate_r, w_gate_i, b_gate_i,
              rg_lambda, w_conv_c, b_conv_c, ln_c_g, ln_c_b, grp_g):

    def trunk(x, c, st_a, st_b, st_h, st_c):
        bsz = x.shape[0]
        new_a, new_b, new_h, new_c = [], [], [], []
        for l in range(DEPTH):
            mod = (jax.nn.silu(c) @ w_ada[l] + b_ada[l]).reshape(bsz, 3 * N_SUB, 1, D_MODEL).astype(x.dtype)
            h = rmsnorm(x, norm_pre[l, 0]) * (1.0 + mod[:, 1]) + mod[:, 0]
            f = swiglu(h, ffn_w1[l, 0], ffn_w3[l, 0], ffn_w2[l, 0])
            x = x + 0.5 * mod[:, 2] * rmsnorm(f, norm_post[l, 0])
            h = rmsnorm(x, norm_pre[l, 1]) * (1.0 + mod[:, 4]) + mod[:, 3]
            m, na, nb, nh, nc = token_mixer(h, st_a[l], st_b[l], st_h[l], st_c[l], w_in[l], w_out[l],
                                            w_conv_a[l], w_conv_b[l], b_conv_b[l], w_gate_r[l], b_gate_r[l],
                                            w_gate_i[l], b_gate_i[l], rg_lambda[l], w_conv_c[l], b_conv_c[l],
                                            ln_c_g[l], ln_c_b[l], grp_g[l])
            x = x + mod[:, 5] * rmsnorm(m, norm_post[l, 1])
            h = rmsnorm(x, norm_pre[l, 2]) * (1.0 + mod[:, 7]) + mod[:, 6]
            f = swiglu(h, ffn_w1[l, 1], ffn_w3[l, 1], ffn_w2[l, 1])
            x = x + 0.5 * mod[:, 8] * rmsnorm(f, norm_post[l, 2])
            new_a.append(na)
            new_b.append(nb)
            new_h.append(nh)
            new_c.append(nc)
        return x, jnp.stack(new_a), jnp.stack(new_b), jnp.stack(new_h), jnp.stack(new_c)

    dt = x_prompt.dtype
    p_a0 = jnp.zeros((DEPTH, BATCH, CONV_A - 1, D_A), dt)
    p_b0 = jnp.zeros((DEPTH, BATCH, CONV_B - 1, D_B), dt)
    p_h0 = jnp.zeros((DEPTH, BATCH, D_B), dt)
    p_c0 = jnp.zeros((DEPTH, BATCH, CONV_C - 1, D_C), dt)
    y_prompt, pa, pb, ph, pc = trunk(x_prompt, c_prompt, p_a0, p_b0, p_h0, p_c0)
    y_sample, sa, sb, sh, sc = trunk(x_sample, c_sample, state_conv_a, state_conv_b, state_rglru, state_conv_c)
    return (y_prompt, y_sample, pa, pb, ph, pc, sa, sb, sh, sc)
```

```cpp
#include <hip/hip_runtime.h>
#include <hip/hip_cooperative_groups.h>
#include <cstdio>
#include <cstdint>
namespace cg = cooperative_groups;
namespace pg8 {
#define PG8_LAS __attribute__((address_space(3)))
typedef unsigned short bf16_t;
typedef short bf16x8 __attribute__((ext_vector_type(8)));
typedef float f32x4 __attribute__((ext_vector_type(4)));
typedef unsigned u32x4 __attribute__((ext_vector_type(4)));
constexpr int BM = 256, BK = 64, HALF = 128, HTB = HALF * BK * 2  , STAGE_BYTES = 8 * HTB, NXCD = 8, WGM = 8;

__host__ __device__ __forceinline__ int lds_byte(int r, int c) { const int st = (r >> 4) * 2 + (c >> 5), rr = r & 15, cc = c & 31, ob = rr * 64 + cc * 2; return st * 1024 + (ob ^ (((ob >> 9) & 1) << 5)); }
__host__ __device__ __forceinline__ void stage_rc(int b, int& R, int& C) { const int st = b / 1024, sb = b % 1024, swz = sb ^ (((sb >> 9) & 1) << 5); R = (st >> 1) * 16 + swz / 64; C = (st & 1) * 32 + (swz % 64) / 2; }
__host__ __device__ __forceinline__ int perm32(int rho) { const int n = rho >> 4, i = rho & 15; return 8 * (i >> 2) + 4 * n + (i & 3); }

struct Unit { int pm, pn, ko; };
struct Gemm { const bf16_t* A; const bf16_t* Bt; int M, N, K, ld; };

struct StaticOrder {
    int nM, nN, nwg, G, c, pm0, nsplit, klen, mode;
    __host__ __device__ void init(int M, int N, int G_, int c_, int pm0_ = 0, int nsplit_ = 1, int klen_ = 0) { nM = M / BM; nN = N / BM; nwg = nM * nN; G = G_; c = c_; pm0 = pm0_; nsplit = nsplit_; klen = klen_; mode = 0; }
    __host__ __device__ bool next(int i, Unit& u) const {
        const long L = (long)i * G + c;
        if (nsplit > 1) { if (L >= (long)nN * nsplit) return false; u.pm = pm0; u.pn = (int)(L % nN); u.ko = (int)(L / nN) * klen; return true; }
        if (mode == 2) { if (i > 0 || c < 0 || c >= 80) return false; if (c < 65) { u.pm = c; u.pn = 8; } else { u.pm = 50 + (c - 65); u.pn = 7; } u.ko = 0; return true; }
        if (mode == 1 && L >= nwg) { const long Lp = L - nwg; if (Lp >= 50) return false; u.pm = (int)Lp; u.pn = 7; u.ko = 0; return true; }
        if (L >= nwg) return false;
        int wgid = (int)L; { const int q = nwg / NXCD, r = nwg % NXCD, xcd = wgid % NXCD, off = wgid / NXCD; wgid = (xcd < r ? xcd * (q + 1) : r * (q + 1) + (xcd - r) * q) + off; }
        const int nig = WGM * nN, gid = wgid / nig, fm = gid * WGM, gsz = (nM - fm) < WGM ? (nM - fm) : WGM;
        u.pm = pm0 + fm + ((wgid % nig) % gsz); u.pn = (wgid % nig) / gsz; u.ko = 0; return true;
    }
    __device__ __forceinline__ void a_ready(const Unit&) const {}
    __device__ __forceinline__ void done(const Unit&) const {}
};

__device__ __forceinline__ unsigned cvt_pk_bf16(float lo, float hi) { unsigned r; asm volatile("v_cvt_pk_bf16_f32 %0, %1, %2" : "=v"(r) : "v"(lo), "v"(hi)); return r; }
typedef float f32x2 __attribute__((ext_vector_type(2)));
__device__ __forceinline__ float fast_sigmoid(float x) { return __builtin_amdgcn_rcpf(1.0f + __builtin_amdgcn_exp2f(-1.44269504089f * x)); }
struct EpiSwiGLU {
    static constexpr bool PERM = true, AFTER_DRAIN = false;
    bf16_t* O; int ldc;
    __device__ __forceinline__ void operator()(const f32x4 (&acc)[2][2][4][2], const Unit& u, int wr, int wc, int fr, int fq) const {
        const int row0 = u.pm * BM + wr * 64 + fr, col0 = u.pn * HALF + wc * 32 + 8 * fq;
#pragma unroll
        for (int ai = 0; ai < 2; ++ai)
#pragma unroll
            for (int m = 0; m < 4; ++m) {
                bf16_t* rowp = O + (size_t)(row0 + ai * HALF + m * 16) * ldc + col0;
                f32x4 g0, g1;
#pragma unroll
                for (int e = 0; e < 4; ++e) {
                    const float a0 = acc[ai][0][m][0][e], a1 = acc[ai][0][m][1][e];
                    g0[e] = a0 * fast_sigmoid(a0) * acc[ai][1][m][0][e];
                    g1[e] = a1 * fast_sigmoid(a1) * acc[ai][1][m][1][e];
                }
                u32x4 w; w.x = cvt_pk_bf16(g0[0], g0[1]); w.y = cvt_pk_bf16(g0[2], g0[3]); w.z = cvt_pk_bf16(g1[0], g1[1]); w.w = cvt_pk_bf16(g1[2], g1[3]);
                *(u32x4*)rowp = w;
            }
    }
};
struct EpiF32 {
    static constexpr bool PERM = true, AFTER_DRAIN = false;
    float* O; int ldc;
    __device__ __forceinline__ void operator()(const f32x4 (&acc)[2][2][4][2], const Unit& u, int wr, int wc, int fr, int fq) const {
        const int row0 = u.pm * BM + wr * 64 + fr, col0 = u.pn * BM + wc * 32 + 8 * fq;
#pragma unroll
        for (int ai = 0; ai < 2; ++ai)
#pragma unroll
            for (int m = 0; m < 4; ++m) {
                float* rowp = O + (size_t)(row0 + ai * HALF + m * 16) * ldc + col0;
#pragma unroll
                for (int bj = 0; bj < 2; ++bj) { *(f32x4*)(rowp + bj * HALF) = acc[ai][bj][m][0]; *(f32x4*)(rowp + bj * HALF + 4) = acc[ai][bj][m][1]; }
            }
    }
};
struct EpiB16 {
    static constexpr bool PERM = true, AFTER_DRAIN = false;
    bf16_t* O; int ldc;
    __device__ __forceinline__ void operator()(const f32x4 (&acc)[2][2][4][2], const Unit& u, int wr, int wc, int fr, int fq) const {
        const int row0 = u.pm * BM + wr * 64 + fr, col0 = u.pn * BM + wc * 32 + 8 * fq;
#pragma unroll
        for (int ai = 0; ai < 2; ++ai)
#pragma unroll
            for (int m = 0; m < 4; ++m) {
                bf16_t* rowp = O + (size_t)(row0 + ai * HALF + m * 16) * ldc + col0;
#pragma unroll
                for (int bj = 0; bj < 2; ++bj) { const f32x4 v0 = acc[ai][bj][m][0], v1 = acc[ai][bj][m][1];
                    u32x4 w; w.x = cvt_pk_bf16(v0[0], v0[1]); w.y = cvt_pk_bf16(v0[2], v0[3]); w.z = cvt_pk_bf16(v1[0], v1[1]); w.w = cvt_pk_bf16(v1[2], v1[3]);
                    *(u32x4*)(rowp + bj * HALF) = w; }
            }
    }
};

struct EpiMulti {
    static constexpr bool PERM = true, AFTER_DRAIN = false;
    int mode; void* O; int ldc;
    __device__ __forceinline__ void operator()(const f32x4 (&acc)[2][2][4][2], const Unit& u, int wr, int wc, int fr, int fq) const {
        if (mode == 0) { EpiSwiGLU e{(bf16_t*)O, ldc}; e(acc, u, wr, wc, fr, fq); }
        else if (mode == 4) { Unit v = u; v.pm = u.ko >> 8; EpiB16 e{(bf16_t*)O, ldc}; e(acc, v, wr, wc, fr, fq); }
        else { EpiB16 e{(bf16_t*)O, ldc}; e(acc, u, wr, wc, fr, fq); }
    }
};
template <class Epi, class Sched, bool ALIGN_EPI = false, bool SP2 = false>
__device__ __forceinline__ void gemm_phase(PG8_LAS unsigned char* lds, const Gemm g, const Sched& S, const Epi& E) {
    const int tid = threadIdx.x, wid = __builtin_amdgcn_readfirstlane(tid >> 6), lane = tid & 63, wr = wid >> 2, wc = wid & 3, fr = lane & 15, fq = lane >> 4;
    const int K = g.ld, nt = g.K / BK;
    unsigned voffA[2], voffB[2];
#pragma unroll
    for (int i = 0; i < 2; ++i) { int R, C; stage_rc(tid * 16 + i * 8192, R, C); const int Rb = Epi::PERM ? ((R & ~31) + perm32(R & 31)) : R;
        voffA[i] = (unsigned)(R * K + C) * 2u; voffB[i] = (unsigned)(Rb * K + C) * 2u; }
    const size_t kstep = (size_t)(BK * 2);
    const size_t hstep = (size_t)HALF * K * 2;
    const size_t tstep = 2 * hstep;
    const unsigned ldsw = (unsigned)wid * 1024u;
    const int aoff = lds_byte(wr * 64 + fr, fq * 8), boff = lds_byte(wc * 32 + fr, fq * 8);
#define PG8_SA(b, h) (((b) * 2 + (h)) * HTB)
#define PG8_SB(b, h) ((4 + (b) * 2 + (h)) * HTB)
#define PG8_STAGE(bufoff, gbase, voff) do { _Pragma("unroll") for (int _i = 0; _i < 2; ++_i) \
        __builtin_amdgcn_global_load_lds((const unsigned*)((const char*)(gbase) + (voff)[_i]), (PG8_LAS unsigned*)(lds + (bufoff) + ldsw + _i * 8192), 16, 0, 0); } while (0)
#define PG8_LDA(dst, b, h) do { _Pragma("unroll") for (int m = 0; m < 4; ++m) _Pragma("unroll") for (int k = 0; k < 2; ++k) dst[m][k] = *(const PG8_LAS bf16x8*)(lds + PG8_SA(b, h) + aoff + m * 2048 + k * 1024); } while (0)
#define PG8_LDB(dst, b, h) do { _Pragma("unroll") for (int n = 0; n < 2; ++n) _Pragma("unroll") for (int k = 0; k < 2; ++k) dst[n][k] = *(const PG8_LAS bf16x8*)(lds + PG8_SB(b, h) + boff + n * 2048 + k * 1024); } while (0)
#define PG8_MMA(ai, bj, At, Bt) do { __builtin_amdgcn_s_setprio(1); _Pragma("unroll") for (int m = 0; m < 4; ++m) _Pragma("unroll") for (int n = 0; n < 2; ++n) _Pragma("unroll") for (int k = 0; k < 2; ++k) \
        acc[ai][bj][m][n] = __builtin_amdgcn_mfma_f32_16x16x32_bf16(Bt[n][k], At[m][k], acc[ai][bj][m][n], 0, 0, 0); __builtin_amdgcn_s_setprio(0); } while (0)
#define PG8_WAIT_V(n) asm volatile("s_waitcnt vmcnt(" #n ")" ::: "memory")
#define PG8_WAIT_L(n) asm volatile("s_waitcnt lgkmcnt(" #n ")" ::: "memory")
#define PG8_BAR __builtin_amdgcn_s_barrier()
#define PG8_SCHED __builtin_amdgcn_sched_barrier(0)
    Unit cur, nxt; int ui = 0;
    if (!S.next(0, cur)) return;
    f32x4 acc[2][2][4][2];
#pragma unroll
    for (int a = 0; a < 2; ++a)
#pragma unroll
        for (int b = 0; b < 2; ++b)
#pragma unroll
            for (int m = 0; m < 4; ++m)
#pragma unroll
                for (int n = 0; n < 2; ++n) acc[a][b][m][n] = (f32x4){0.f, 0.f, 0.f, 0.f};
    bf16x8 At[4][2], B0[2][2], B1[2][2];
    const char* cA = (const char*)g.A + (size_t)cur.pm * tstep + (size_t)cur.ko * 2; const char* cB = (const char*)g.Bt + (size_t)cur.pn * tstep + (size_t)cur.ko * 2;
    S.a_ready(cur);
    if constexpr (SP2) {
        PG8_STAGE(PG8_SB(0, 0), cB, voffB); PG8_STAGE(PG8_SB(0, 1), cB + hstep, voffB); PG8_STAGE(PG8_SA(0, 0), cA, voffA); PG8_STAGE(PG8_SA(0, 1), cA + hstep, voffA);
        if (wr == 1) PG8_BAR;
        PG8_WAIT_V(2); PG8_BAR;
        PG8_STAGE(PG8_SB(1, 0), cB + kstep, voffB); PG8_STAGE(PG8_SA(1, 0), cA + kstep, voffA); PG8_STAGE(PG8_SB(1, 1), cB + hstep + kstep, voffB);
        PG8_WAIT_V(6); PG8_BAR;
    } else {
        PG8_STAGE(PG8_SB(0, 0), cB, voffB); PG8_STAGE(PG8_SA(0, 0), cA, voffA); PG8_STAGE(PG8_SB(0, 1), cB + hstep, voffB); PG8_STAGE(PG8_SA(0, 1), cA + hstep, voffA);
        if (wr == 1) PG8_BAR;
        PG8_WAIT_V(4); PG8_BAR;
        PG8_STAGE(PG8_SB(1, 0), cB + kstep, voffB); PG8_STAGE(PG8_SA(1, 0), cA + kstep, voffA); PG8_STAGE(PG8_SB(1, 1), cB + hstep + kstep, voffB);
        PG8_WAIT_V(6); PG8_BAR;
    }
    for (;;) {
        const bool has_next = S.next(ui + 1, nxt);
        const char* nA = has_next ? (const char*)g.A + (size_t)nxt.pm * tstep + (size_t)nxt.ko * 2 : cA; const char* nB = has_next ? (const char*)g.Bt + (size_t)nxt.pn * tstep + (size_t)nxt.ko * 2 : cB;
        for (int t = 0; t < nt; t += 2) {
            const bool last = (t == nt - 2);
            const char* a1 = cA + (size_t)(t + 1) * kstep;
            const char* a2 = last ? nA : cA + (size_t)(t + 2) * kstep; const char* b2 = last ? nB : cB + (size_t)(t + 2) * kstep;
            const char* a3 = a2 + kstep; const char* b3 = b2 + kstep;
            if (last && has_next) S.a_ready(nxt);
            if constexpr (SP2) {
            PG8_LDB(B0, 0, 0); PG8_LDB(B1, 0, 1); PG8_SCHED; PG8_LDA(At, 0, 0); PG8_STAGE(PG8_SA(1, 1), a1 + hstep, voffA);
            PG8_WAIT_V(8); PG8_WAIT_L(0); PG8_BAR; PG8_MMA(0, 0, At, B0); PG8_MMA(0, 1, At, B1); PG8_BAR; PG8_SCHED;
            PG8_LDA(At, 0, 1); PG8_STAGE(PG8_SB(0, 0), b2, voffB); PG8_STAGE(PG8_SB(0, 1), b2 + hstep, voffB); PG8_STAGE(PG8_SA(0, 0), a2, voffA);
            PG8_WAIT_V(8); PG8_WAIT_L(0); PG8_BAR; PG8_MMA(1, 0, At, B0); PG8_MMA(1, 1, At, B1); PG8_BAR; PG8_SCHED;
            PG8_LDB(B0, 1, 0); PG8_LDB(B1, 1, 1); PG8_SCHED; PG8_LDA(At, 1, 0); PG8_STAGE(PG8_SA(0, 1), a2 + hstep, voffA);
            PG8_WAIT_V(8); PG8_WAIT_L(0); PG8_BAR; PG8_MMA(0, 0, At, B0); PG8_MMA(0, 1, At, B1); PG8_BAR; PG8_SCHED;
            PG8_LDA(At, 1, 1); PG8_STAGE(PG8_SB(1, 0), b3, voffB); PG8_STAGE(PG8_SB(1, 1), b3 + hstep, voffB); PG8_STAGE(PG8_SA(1, 0), a3, voffA);
            PG8_WAIT_V(8); PG8_WAIT_L(0); PG8_BAR; PG8_MMA(1, 0, At, B0); PG8_MMA(1, 1, At, B1); PG8_BAR; PG8_SCHED;
            } else {
            PG8_LDB(B0, 0, 0); PG8_SCHED; PG8_LDA(At, 0, 0); PG8_STAGE(PG8_SA(1, 1), a1 + hstep, voffA);
            PG8_WAIT_L(8); PG8_BAR; PG8_WAIT_L(0); PG8_MMA(0, 0, At, B0); PG8_BAR; PG8_SCHED;
            PG8_LDB(B1, 0, 1); PG8_STAGE(PG8_SB(0, 0), b2, voffB);
            PG8_BAR; PG8_WAIT_L(0); PG8_MMA(0, 1, At, B1); PG8_BAR;
            PG8_LDA(At, 0, 1); PG8_STAGE(PG8_SA(0, 0), a2, voffA);
            PG8_BAR; PG8_WAIT_L(0); PG8_MMA(1, 0, At, B0); PG8_BAR; PG8_SCHED;
            PG8_STAGE(PG8_SB(0, 1), b2 + hstep, voffB);
            PG8_WAIT_V(6); PG8_BAR; PG8_MMA(1, 1, At, B1); PG8_BAR;
            PG8_LDB(B0, 1, 0); PG8_SCHED; PG8_LDA(At, 1, 0); PG8_STAGE(PG8_SA(0, 1), a2 + hstep, voffA);
            PG8_WAIT_L(8); PG8_BAR; PG8_WAIT_L(0); PG8_MMA(0, 0, At, B0); PG8_BAR; PG8_SCHED;
            PG8_LDB(B1, 1, 1); PG8_STAGE(PG8_SB(1, 0), b3, voffB);
            PG8_BAR; PG8_WAIT_L(0); PG8_MMA(0, 1, At, B1); PG8_BAR;
            PG8_LDA(At, 1, 1); PG8_STAGE(PG8_SA(1, 0), a3, voffA);
            PG8_BAR; PG8_WAIT_L(0); PG8_MMA(1, 0, At, B0); PG8_BAR; PG8_SCHED;
            PG8_STAGE(PG8_SB(1, 1), b3 + hstep, voffB);
            PG8_WAIT_V(6); PG8_BAR; PG8_MMA(1, 1, At, B1); PG8_BAR;
            }
        }
        if constexpr (ALIGN_EPI) { if (wr == 0) PG8_BAR; }
        if constexpr (!Epi::AFTER_DRAIN) { E(acc, cur, wr, wc, fr, fq); S.done(cur); }
        if (!has_next) break;
#pragma unroll
        for (int a = 0; a < 2; ++a)
#pragma unroll
            for (int b = 0; b < 2; ++b)
#pragma unroll
                for (int m = 0; m < 4; ++m)
#pragma unroll
                    for (int n = 0; n < 2; ++n) acc[a][b][m][n] = (f32x4){0.f, 0.f, 0.f, 0.f};
        cur = nxt; cA = nA; cB = nB; ++ui;
        if constexpr (ALIGN_EPI) { if (wr == 1) PG8_BAR; }
    }
    PG8_WAIT_V(0);
    if constexpr (!ALIGN_EPI) { if (wr == 0) PG8_BAR; }
    PG8_BAR;
    if constexpr (Epi::AFTER_DRAIN) { E.fused(acc, cur, wr, wc, fr, fq, lds, wid, lane); S.done(cur); }
#undef PG8_SA
#undef PG8_SB
#undef PG8_STAGE
#undef PG8_LDA
#undef PG8_LDB
#undef PG8_MMA
#undef PG8_WAIT_V
#undef PG8_WAIT_L
#undef PG8_BAR
#undef PG8_SCHED
}
}

#ifndef MK_NO_PRO
#define MK_NO_PRO 0
#endif
#ifndef MK_NO_MIX1
#define MK_NO_MIX1 0
#endif
#ifndef MK_NO_MIX2
#define MK_NO_MIX2 0
#endif
#ifndef MK_NO_G1
#define MK_NO_G1 0
#endif
#ifndef MK_NO_G2
#define MK_NO_G2 0
#endif
#ifndef MK_NO_G3
#define MK_NO_G3 0
#endif
#ifndef MK_CHECK
#define MK_CHECK 0
#endif
#ifndef MK_PROBE
#define MK_PROBE 0
#endif
#ifndef MK_DEFER_WIN
#define MK_DEFER_WIN 1
#endif
#ifndef MK_ONE_LAUNCH
#define MK_ONE_LAUNCH 1
#endif
namespace mk {
#define LAS __attribute__((address_space(3)))
typedef unsigned short bf16_t;
typedef float f32x4 __attribute__((ext_vector_type(4)));
typedef unsigned u32x4 __attribute__((ext_vector_type(4)));
typedef unsigned u32x2 __attribute__((ext_vector_type(2)));
constexpr int NWAVES = 8, NTHR = 512;
constexpr int D = 1024, TP = 16384, NSB = 8, TSS = 16, MV = 16512, MP = 16640, DFF = 2816, DIN = 2304, NL = 4;
constexpr int DA = 256, DB = 512, DC = 256;
constexpr int COL_AB = 0, COL_AC = 256, COL_AX = 512, COL_BX = 768, COL_BG = 1280, COL_CV = 1792, COL_CG = 2048;
constexpr float EPS = 1e-6f;
constexpr int LDS_BYTES = 147456;
constexpr size_t MiB = 1u << 20;
constexpr size_t WS_W13 = 1 * MiB, WS_W2 = 89 * MiB, WS_WIN = 133 * MiB, WS_WOUT = 151 * MiB, WS_MOD = 159 * MiB, WS_AGG = 161 * MiB,
                 WS_X = 163 * MiB, WS_F = 228 * MiB, WS_H = 293 * MiB, WS_Y = 326 * MiB, WS_HL = 359 * MiB, WS_AC = 392 * MiB, WS_GU = 425 * MiB, WS_FPART = 515 * MiB, WS_END = 521 * MiB;
constexpr size_t W13_BYTES = (size_t)2 * DFF * D * 2, W2_BYTES = (size_t)D * DFF * 2, WIN_BYTES = (size_t)DIN * D * 2, WOUT_BYTES = (size_t)D * D * 2;
constexpr size_t O_Y = 0, O_CAP = 16908288, O_CBP = 16910336, O_HP = 16916480, O_CCP = 16918528, O_CAS = 16949248, O_CBS = 16965632, O_HS = 17014784, O_CCS = 17031168, O_END = 17276928;
constexpr int NPH = 2 + 11 * NL;
constexpr int NSTEP = MK_PROBE == 4 ? NPH + 1 : (MK_PROBE == 2 || MK_PROBE == 3) ? 2 + 12 * NL : (MK_PROBE == 5 || MK_PROBE == 6) ? 2 + 14 * NL : NPH;
constexpr int NCHUNK = 256 + NSB;

struct Args { const float* in[30]; float* out; unsigned char* ws; int ph_lo, ph_hi; };
typedef const __attribute__((address_space(4))) Args* CArgs;
enum { I_XP = 0, I_XS, I_SA, I_SB, I_SH, I_SC, I_CP, I_CS, I_WADA, I_BADA, I_NPRE, I_NPOST, I_W1, I_W3, I_W2, I_WIN, I_WOUT, I_WCA, I_WCB, I_BCB,
       I_WGR, I_BGR, I_WGI, I_BGI, I_LAM, I_WCC, I_BCC, I_LNG, I_LNB, I_GRP };

__device__ __forceinline__ float wave_sum_l(float v, int lane) {
#pragma unroll
    for (int o = 1; o < 64; o <<= 1) v += __builtin_bit_cast(float, __builtin_amdgcn_ds_bpermute((lane ^ o) << 2, __builtin_bit_cast(int, v)));
    return v;
}
#define wave_sum(v) wave_sum_l((v), lane)
#define LDS_BARRIER() do { asm volatile("s_waitcnt lgkmcnt(0)" ::: "memory"); __builtin_amdgcn_s_barrier(); asm volatile("" ::: "memory"); } while (0)
__device__ __forceinline__ void wave_sum4_l(float& a, float& b, float& c, float& d, int lane) {
#pragma unroll
    for (int o = 1; o < 64; o <<= 1) { const int idx = (lane ^ o) << 2;
        const float a2 = __builtin_bit_cast(float, __builtin_amdgcn_ds_bpermute(idx, __builtin_bit_cast(int, a))), b2 = __builtin_bit_cast(float, __builtin_amdgcn_ds_bpermute(idx, __builtin_bit_cast(int, b)));
        const float c2 = __builtin_bit_cast(float, __builtin_amdgcn_ds_bpermute(idx, __builtin_bit_cast(int, c))), d2 = __builtin_bit_cast(float, __builtin_amdgcn_ds_bpermute(idx, __builtin_bit_cast(int, d)));
        a += a2; b += b2; c += c2; d += d2; }
}
__device__ __forceinline__ unsigned f2bf(float f) { unsigned u = __builtin_bit_cast(unsigned, f); return (u + 0x7fffu + ((u >> 16) & 1u)) >> 16; }
__device__ __forceinline__ unsigned pk2(float lo, float hi) { unsigned r; asm("v_cvt_pk_bf16_f32 %0, %1, %2" : "=v"(r) : "v"(lo), "v"(hi)); return r; }
__device__ __forceinline__ float bflo(unsigned u) { return __builtin_bit_cast(float, u << 16); }
__device__ __forceinline__ float bfhi(unsigned u) { return __builtin_bit_cast(float, u & 0xffff0000u); }
__device__ __forceinline__ f32x4 ld_bf4(const bf16_t* p) { const u32x2 v = *(const u32x2*)p; return (f32x4){bflo(v.x), bfhi(v.x), bflo(v.y), bfhi(v.y)}; }
__device__ __forceinline__ float bf1(const bf16_t* p) { return __builtin_bit_cast(float, (unsigned)(*p) << 16); }
__device__ __forceinline__ float sigm(float x) { return __builtin_amdgcn_rcpf(1.0f + __builtin_amdgcn_exp2f(-1.44269504089f * x)); }
__device__ __forceinline__ float gelu_tanh(float x) { return x * sigm(1.5957691216f * (x + 0.044715f * x * x * x)); }
__device__ __forceinline__ float hsum4(f32x4 v) { return (v[0] + v[1]) + (v[2] + v[3]); }
__device__ __forceinline__ float hsq4(f32x4 v) { return (v[0] * v[0] + v[1] * v[1]) + (v[2] * v[2] + v[3] * v[3]); }

__device__ __forceinline__ void transpose_item(const float* W, int K, int N, bf16_t* WT, LAS float* scr, int kb, int nb, int dst_row0, int lane) {
    const int k0 = 64 * kb, n0 = 32 * nb;
#pragma unroll 8
    for (int i = 0; i < 32; ++i) { const int kk = 2 * i + (lane >> 5); scr[kk * 33 + (lane & 31)] = W[(size_t)(k0 + kk) * N + n0 + (lane & 31)]; }
    asm volatile("s_waitcnt lgkmcnt(0)" ::: "memory");
    const int c = lane & 7;
#pragma unroll
    for (int j = 0; j < 4; ++j) { const int n = (lane >> 3) + 8 * j; const LAS float* s = scr + (8 * c) * 33 + n;
        u32x4 o; o.x = pk2(s[0 * 33], s[1 * 33]); o.y = pk2(s[2 * 33], s[3 * 33]); o.z = pk2(s[4 * 33], s[5 * 33]); o.w = pk2(s[6 * 33], s[7 * 33]);
        *(u32x4*)(WT + (size_t)(dst_row0 + n) * K + k0 + 8 * c) = o; }
    asm volatile("s_waitcnt lgkmcnt(0)" ::: "memory");
}

__device__ __forceinline__ void phase_prologue(CArgs a, LAS unsigned char* lds, int tid, int lane, int wave) {
    unsigned char* ws = a->ws;
    {
        LAS float* sc = (LAS float*)lds;
        LAS float* red = sc + 9 * 1024;
        for (int e = tid; e < 9 * 1024; e += NTHR) { const int b = e >> 10, k = e & 1023; const float c = b == 0 ? a->in[I_CP][k] : a->in[I_CS][(b - 1) * 1024 + k]; sc[e] = c * sigm(c); }
        __syncthreads();
        float* mod = (float*)(ws + WS_MOD);
        const int kk = tid >> 5, cl = tid & 31;
        for (int u = blockIdx.x; u < NL * 72; u += gridDim.x) {
            const int l = u / 72, n0 = 128 * (u % 72);
            f32x4 acc[9];
#pragma unroll
            for (int b = 0; b < 9; ++b) acc[b] = (f32x4){0.f, 0.f, 0.f, 0.f};
            const float* wp = a->in[I_WADA] + (size_t)l * 1024 * 9216 + n0 + 4 * cl;
#pragma unroll 4
            for (int k = kk; k < 1024; k += 16) {
                const f32x4 w = *(const f32x4*)(wp + (size_t)k * 9216);
#pragma unroll
                for (int b = 0; b < 9; ++b) acc[b] += sc[b * 1024 + k] * w;
            }
#pragma unroll
            for (int b = 0; b < 9; ++b)
#pragma unroll
                for (int e = 0; e < 4; ++e) { const float av = acc[b][e]; acc[b][e] = av + __builtin_bit_cast(float, __builtin_amdgcn_ds_bpermute((lane ^ 32) << 2, __builtin_bit_cast(int, av))); }
            if (lane < 32) {
#pragma unroll
                for (int b = 0; b < 9; ++b) *(LAS f32x4*)(red + (wave * 9 + b) * 128 + 4 * cl) = acc[b];
            }
            __syncthreads();
            for (int o = tid; o < 9 * 128; o += NTHR) {
                const int b = o >> 7, c = o & 127; float s = 0.f;
#pragma unroll
                for (int w = 0; w < 8; ++w) s += red[(w * 9 + b) * 128 + c];
                mod[((size_t)l * 9 + b) * 9216 + n0 + c] = s + a->in[I_BADA][l * 9216 + n0 + c];
            }
            __syncthreads();
        }
    }
    __syncthreads();
    {
        LAS float* scr = (LAS float*)(lds + wave * 8448);
        const int gw = blockIdx.x * NWAVES + wave, NGW = gridDim.x * NWAVES;
        constexpr int I13 = 16 * 88, I2 = 44 * 32, IIN = 16 * 72, IOUT = 16 * 32;
        constexpr int PER_L = 4 * I13 + 2 * I2 + IIN + IOUT;
        for (int it = gw; it < NL * PER_L; it += NGW) {
            const int l = it / PER_L; int r = it % PER_L;
            if (r < 4 * I13) {
                const int which = r / (2 * I13); r %= 2 * I13; const int s = r / I13, q = r % I13, kb = q / 88, nb = q % 88;
                const float* W = a->in[which ? I_W3 : I_W1] + (size_t)(l * 2 + s) * D * DFF;
                bf16_t* WT = (bf16_t*)(ws + WS_W13 + (size_t)(l * 2 + s) * W13_BYTES);
                const int n0 = 32 * nb, dst = (n0 >> 7) * 256 + (n0 & 127) + (which ? 128 : 0);
                transpose_item(W, D, DFF, WT, scr, kb, nb, dst, lane);
                continue;
            }
            r -= 4 * I13;
            if (r < 2 * I2) {
                const int s = r / I2, q = r % I2, kb = q / 32, nb = q % 32;
                transpose_item(a->in[I_W2] + (size_t)(l * 2 + s) * DFF * D, DFF, D, (bf16_t*)(ws + WS_W2 + (size_t)(l * 2 + s) * W2_BYTES), scr, kb, nb, 32 * nb, lane);
                continue;
            }
            r -= 2 * I2;
            if (r < IIN) { const int kb = r / 72, nb = r % 72;
                transpose_item(a->in[I_WIN] + (size_t)l * D * DIN, D, DIN, (bf16_t*)(ws + WS_WIN + (size_t)l * WIN_BYTES), scr, kb, nb, 32 * nb, lane); continue; }
            r -= IIN;
            { const int kb = r / 32, nb = r % 32;
                transpose_item(a->in[I_WOUT] + (size_t)l * D * D, D, D, (bf16_t*)(ws + WS_WOUT + (size_t)l * WOUT_BYTES), scr, kb, nb, 32 * nb, lane); }
        }
    }
}

__device__ __forceinline__ void phase_rows(CArgs a, int lane, int wave, int mode, bool final_, float coef, int nsplit,
                                           const float* modc, int gidx, const float* gpost, const float* modn, int scidx, int shidx, const float* gpre) {
    unsigned char* ws = a->ws;
    bf16_t* X = (bf16_t*)(ws + WS_X); const bf16_t* Fb = (const bf16_t*)(ws + WS_F); bf16_t* H = (bf16_t*)(ws + WS_H);
    const int gw = blockIdx.x * NWAVES + wave, NGW = gridDim.x * NWAVES;
    {
        f32x4 gg[4], gs[4], tt[4];
#pragma unroll
        for (int j = 0; j < 4; ++j) { const int c = 4 * lane + 256 * j;
            gg[j] = mode ? coef * *(const f32x4*)(modc + (size_t)gidx * D + c) * *(const f32x4*)(gpost + c) : (f32x4){0.f, 0.f, 0.f, 0.f};
            gs[j] = *(const f32x4*)(gpre + c) * (1.0f + *(const f32x4*)(modn + (size_t)scidx * D + c));
            tt[j] = *(const f32x4*)(modn + (size_t)shidx * D + c); }
        const float* xin = a->in[I_XP];
        constexpr int LA = 3;
        u32x2 xq[LA + 1][4], fq[LA + 1][4]; f32x4 xf[LA + 1][4];
#define ROWS_LOAD(S_, R_) do { if ((R_) < TP) { _Pragma("unroll") for (int j = 0; j < 4; ++j) { const size_t o_ = (size_t)(R_) * D + 4 * lane + 256 * j; \
            if (mode) { xq[S_][j] = *(const u32x2*)(X + o_); fq[S_][j] = *(const u32x2*)(Fb + o_); } else xf[S_][j] = *(const f32x4*)(xin + o_); } } } while (0)
        int r = gw;
        ROWS_LOAD(0, r); ROWS_LOAD(1, r + NGW); ROWS_LOAD(2, r + 2 * NGW);
        while (r < TP) {
            ROWS_LOAD(3, r + 3 * NGW);
            f32x4 x[4];
            if (mode) {
                f32x4 f[4]; float ss = 0.f;
#pragma unroll
                for (int j = 0; j < 4; ++j) { f[j] = (f32x4){bflo(fq[0][j].x), bfhi(fq[0][j].x), bflo(fq[0][j].y), bfhi(fq[0][j].y)}; ss += hsq4(f[j]); }
                const float rstd = __builtin_amdgcn_rsqf(wave_sum(ss) * (1.0f / D) + EPS);
#pragma unroll
                for (int j = 0; j < 4; ++j) x[j] = (f32x4){bflo(xq[0][j].x), bfhi(xq[0][j].x), bflo(xq[0][j].y), bfhi(xq[0][j].y)} + gg[j] * (f[j] * rstd);
            } else {
#pragma unroll
                for (int j = 0; j < 4; ++j) x[j] = xf[0][j];
            }
            if (final_) {
#pragma unroll
                for (int j = 0; j < 4; ++j) *(f32x4*)(a->out + (size_t)r * D + 4 * lane + 256 * j) = x[j];
            } else {
                float ss = 0.f;
#pragma unroll
                for (int j = 0; j < 4; ++j) { u32x2 xo; xo.x = pk2(x[j][0], x[j][1]); xo.y = pk2(x[j][2], x[j][3]); *(u32x2*)(X + (size_t)r * D + 4 * lane + 256 * j) = xo;
                    x[j] = (f32x4){bflo(xo.x), bfhi(xo.x), bflo(xo.y), bfhi(xo.y)}; ss += hsq4(x[j]); }
                const float rstd = __builtin_amdgcn_rsqf(wave_sum(ss) * (1.0f / D) + EPS);
#pragma unroll
                for (int j = 0; j < 4; ++j) { const f32x4 h = (x[j] * rstd) * gs[j] + tt[j];
                    u32x2 o; o.x = pk2(h[0], h[1]); o.y = pk2(h[2], h[3]);
                    *(u32x2*)(H + (size_t)r * D + 4 * lane + 256 * j) = o; }
            }
#pragma unroll
            for (int s = 0; s < LA; ++s)
#pragma unroll
                for (int j = 0; j < 4; ++j) { xq[s][j] = xq[s + 1][j]; fq[s][j] = fq[s + 1][j]; xf[s][j] = xf[s + 1][j]; }
            r += NGW;
        }
#undef ROWS_LOAD
    }
    for (int r = TP + gw; r < MV; r += NGW) {
        const int bidx = 1 + ((r - TP) >> 4);
        f32x4 x[4];
        if (mode == 0) {
            const float* src = a->in[I_XS] + (size_t)(r - TP) * D;
#pragma unroll
            for (int j = 0; j < 4; ++j) x[j] = *(const f32x4*)(src + 4 * lane + 256 * j);
        } else {
            f32x4 f[4]; float ss = 0.f;
#pragma unroll
            for (int j = 0; j < 4; ++j) {
                u32x2 pr[11];
#pragma unroll
                for (int s = 0; s < 11; ++s) pr[s] = s < nsplit ? *(const u32x2*)((const bf16_t*)(ws + WS_FPART) + ((size_t)s * 256 + (r - TP)) * D + 4 * lane + 256 * j) : (u32x2){0u, 0u};
                f[j] = (f32x4){0.f, 0.f, 0.f, 0.f};
#pragma unroll
                for (int s = 0; s < 11; ++s) f[j] += (f32x4){bflo(pr[s].x), bfhi(pr[s].x), bflo(pr[s].y), bfhi(pr[s].y)};
                ss += hsq4(f[j]); }
#pragma unroll
            for (int j = 0; j < 4; ++j) x[j] = ld_bf4(X + (size_t)r * D + 4 * lane + 256 * j);
            const float rstd = coef * __builtin_amdgcn_rsqf(wave_sum(ss) * (1.0f / D) + EPS);
            const float* gate = modc + ((size_t)bidx * 9 + gidx) * D;
#pragma unroll
            for (int j = 0; j < 4; ++j) { const f32x4 g = *(const f32x4*)(gate + 4 * lane + 256 * j), gp = *(const f32x4*)(gpost + 4 * lane + 256 * j);
                x[j] += g * (f[j] * rstd * gp); }
        }
        if (final_) {
#pragma unroll
            for (int j = 0; j < 4; ++j) *(f32x4*)(a->out + (size_t)r * D + 4 * lane + 256 * j) = x[j];
        } else {
            float ss = 0.f;
#pragma unroll
            for (int j = 0; j < 4; ++j) { u32x2 xo; xo.x = pk2(x[j][0], x[j][1]); xo.y = pk2(x[j][2], x[j][3]); *(u32x2*)(X + (size_t)r * D + 4 * lane + 256 * j) = xo;
                x[j] = (f32x4){bflo(xo.x), bfhi(xo.x), bflo(xo.y), bfhi(xo.y)}; ss += hsq4(x[j]); }
            const float rstd = __builtin_amdgcn_rsqf(wave_sum(ss) * (1.0f / D) + EPS);
            const float* sc = modn + ((size_t)bidx * 9 + scidx) * D; const float* sh = modn + ((size_t)bidx * 9 + shidx) * D;
#pragma unroll
            for (int j = 0; j < 4; ++j) { const int c = 4 * lane + 256 * j;
                const f32x4 g = *(const f32x4*)(gpre + c), s = *(const f32x4*)(sc + c), t = *(const f32x4*)(sh + c);
                const f32x4 h = (x[j] * rstd * g) * (1.0f + s) + t;
                u32x2 o; o.x = pk2(h[0], h[1]); o.y = pk2(h[2], h[3]);
                *(u32x2*)(H + (size_t)r * D + c) = o; }
        }
    }
}

typedef short bf16x8v __attribute__((ext_vector_type(8)));
typedef float f32x16 __attribute__((ext_vector_type(16)));
__device__ __forceinline__ void phase_mix1(CArgs a, LAS unsigned char* lds, int l, int tid, int lane, int wave, bool defer_win) {
    unsigned char* ws = a->ws;
    const bf16_t* U = (const bf16_t*)(ws + WS_GU);
    float* AGG = (float*)(ws + WS_AGG);
    LAS bf16_t* XB = (LAS bf16_t*)lds;
    LAS bf16_t* WT = XB + 64 * 72;
    LAS float* PRE = (LAS float*)(WT + 2 * 64 * 72);
    LAS float* comb = PRE + 2 * 64 * 64;
    const int j = lane, tg = wave;
    const int mg = wave & 1, mtb = (wave >> 1) & 1, mjb = wave >> 2, mr = lane & 31, mh = lane >> 5;
    float wcb[4];
    float br = 0.f, bi = 0.f, lsig = 0.f, bcb = 0.f;
    int cur_head = -1;
    unsigned* HLAC = (unsigned*)(ws + WS_HL);
    float bx[11];
    unsigned short rawu[11]; float raws[11];
#define MIX1_ISSUE(W_) do { const int head_ = (W_) & 7, chunk_ = (W_) >> 3, chg_ = 64 * head_ + j; const bool smp_ = chunk_ >= 256; \
        const int sb_ = smp_ ? chunk_ - 256 : 0, row0_ = smp_ ? TP + TSS * sb_ : 64 * chunk_; \
        const float* sbp_ = a->in[I_SB] + (size_t)(l * NSB + sb_) * 3 * DB + chg_; \
        _Pragma("unroll") for (int q = 0; q < 11; ++q) { const int t_ = tg * 8 - 3 + q; int ru_ = row0_ + t_; \
            ru_ = ru_ < 0 ? 0 : (ru_ > MV - 1 ? MV - 1 : ru_); int si_ = 3 + t_; si_ = si_ < 0 ? 0 : (si_ > 2 ? 2 : si_); \
            rawu[q] = U[(size_t)ru_ * DIN + COL_BX + chg_]; raws[q] = sbp_[(size_t)si_ * DB]; } \
        __builtin_amdgcn_sched_barrier(0); } while (0)
#define MIX1_CONSUME(W_) do { const int chunk_ = (W_) >> 3; const bool smp_ = chunk_ >= 256; \
        const int row0_ = smp_ ? TP + TSS * (chunk_ - 256) : 64 * chunk_, len_ = smp_ ? TSS : 64; \
        _Pragma("unroll") for (int q = 0; q < 11; ++q) { const int t_ = tg * 8 - 3 + q; const int ru_ = row0_ + t_; \
            const bool uok_ = (t_ < len_) && (ru_ >= 0) && (t_ >= 0 || !smp_), sok_ = smp_ && t_ < 0; \
            bx[q] = __builtin_bit_cast(float, (unsigned)rawu[q] << 16) * (uok_ ? 1.0f : 0.0f) + raws[q] * (sok_ ? 1.0f : 0.0f); } } while (0)
    int w0 = (int)blockIdx.x, wstep = (int)gridDim.x, wend = 8 * NCHUNK;
    if (defer_win) { const int hd = (int)blockIdx.x & 7, rk = (int)blockIdx.x >> 3;
        if (rk < 22) { w0 = rk * 8 + hd; wstep = 22 * 8; wend = 214 * 8; } else { w0 = (214 + rk - 22) * 8 + hd; wstep = 10 * 8; wend = 8 * NCHUNK; } }
    if (w0 < wend) MIX1_ISSUE(w0);
    for (int w = w0; w < wend; w += wstep) {
        const int head = w & 7, chunk = w >> 3, chg = 64 * head + j;
        if (head != cur_head) {
            cur_head = head;
            LDS_BARRIER();
            const float* pr = a->in[I_WGR] + (size_t)(l * 8 + head) * 4096; const float* pi = a->in[I_WGI] + (size_t)(l * 8 + head) * 4096;
            for (int e = tid; e < 4096; e += NTHR) { const int k = e >> 6, jj = e & 63; WT[jj * 72 + k] = (bf16_t)f2bf(pr[e]); WT[64 * 72 + jj * 72 + k] = (bf16_t)f2bf(pi[e]); }
            br = a->in[I_BGR][l * DB + chg]; bi = a->in[I_BGI][l * DB + chg];
            const float lam = a->in[I_LAM][l * DB + chg]; lsig = -log1pf(expf(-lam));
#pragma unroll
            for (int k = 0; k < 4; ++k) wcb[k] = a->in[I_WCB][(l * 4 + k) * DB + chg];
            bcb = a->in[I_BCB][l * DB + chg];
        }
        int row0, len;
        if (chunk < 256) { row0 = 64 * chunk; len = 64; } else { row0 = TP + TSS * (chunk - 256); len = TSS; }
        MIX1_CONSUME(w);
        float xb[8];
#pragma unroll
        for (int i = 0; i < 8; ++i) { xb[i] = bcb + wcb[0] * bx[i] + wcb[1] * bx[i + 1] + wcb[2] * bx[i + 2] + wcb[3] * bx[i + 3]; XB[(tg * 8 + i) * 72 + j] = (bf16_t)f2bf(xb[i]); }
        LDS_BARRIER();
        if (w + wstep < wend) MIX1_ISSUE(w + wstep);
        {
            f32x16 acc;
#pragma unroll
            for (int i = 0; i < 16; ++i) acc[i] = 0.f;
#pragma unroll
            for (int ks = 0; ks < 4; ++ks) {
                const bf16x8v av = *(const LAS bf16x8v*)(XB + (mtb * 32 + mr) * 72 + ks * 16 + 8 * mh);
                const bf16x8v bv = *(const LAS bf16x8v*)(WT + mg * 64 * 72 + (mjb * 32 + mr) * 72 + ks * 16 + 8 * mh);
                acc = __builtin_amdgcn_mfma_f32_32x32x16_bf16(av, bv, acc, 0, 0, 0);
            }
#pragma unroll
            for (int i = 0; i < 16; ++i) PRE[(mg * 64 + mtb * 32 + (i & 3) + 8 * (i >> 2) + 4 * mh) * 64 + mjb * 32 + mr] = acc[i];
        }
        LDS_BARRIER();
        float hl[8], ac[8]; float Ac = 1.f, hc = 0.f;
#pragma unroll
        for (int t = 0; t < 8; ++t) {
            if (tg * 8 + t < len) {
                const float r = sigm(br + PRE[(tg * 8 + t) * 64 + j]), ig = sigm(bi + PRE[(64 + tg * 8 + t) * 64 + j]);
                const float la = 8.0f * r * lsig, av = __expf(la);
                const float bt = __builtin_amdgcn_sqrtf(fmaxf(1.0f - av * av, 0.f)) * ig * xb[t];
                hc = av * hc + bt; Ac *= av;
            }
            hl[t] = hc; ac[t] = Ac;
        }
        comb[(tg * 2 + 0) * 64 + j] = Ac; comb[(tg * 2 + 1) * 64 + j] = hc;
        LDS_BARRIER();
        float Ap = 1.f, Hp = 0.f;
        for (int g = 0; g < tg; ++g) { const float Ag = comb[(g * 2) * 64 + j], Hg = comb[(g * 2 + 1) * 64 + j]; Hp = Ag * Hp + Hg; Ap *= Ag; }
#pragma unroll
        for (int t = 0; t < 8; ++t) {
            if (tg * 8 + t < len) HLAC[(size_t)(row0 + tg * 8 + t) * DB + chg] = pk2(hl[t] + ac[t] * Hp, ac[t] * Ap);
        }
        if (tg == 7) { AGG[((size_t)chunk * 2 + 0) * DB + chg] = ac[7] * Ap; AGG[((size_t)chunk * 2 + 1) * DB + chg] = hl[7] + ac[7] * Hp; }
        LDS_BARRIER();
    }
#undef MIX1_ISSUE
#undef MIX1_CONSUME
}

__device__ __forceinline__ void phase_mix2(CArgs a, LAS unsigned char* lds, int l, int tid, int lane, int wave) {
    unsigned char* ws = a->ws;
    const bf16_t* U = (const bf16_t*)(ws + WS_GU); bf16_t* Y = (bf16_t*)(ws + WS_Y);
    const unsigned* HLAC = (const unsigned*)(ws + WS_HL); const float* AGG = (const float*)(ws + WS_AGG);
    LAS float* vs = (LAS float*)lds;
    LAS float* carry = vs + 62 * 256;
    const int c4 = 4 * lane, c8 = 8 * lane;
    LAS float* wcs = carry + 512;
    for (int e = tid; e < 31 * 64; e += NTHR) *(LAS f32x4*)(wcs + 4 * e) = *(const f32x4*)(a->in[I_WCC] + (size_t)l * 31 * DC + 4 * e);
    const float* bccp = a->in[I_BCC] + l * DC + c4; const float* lngp = a->in[I_LNG] + l * DC + c4; const float* lnbp = a->in[I_LNB] + l * DC + c4;
    const float* grp = a->in[I_GRP] + l * D;
    const float* wap = a->in[I_WCA] + (size_t)l * 3 * DA + c4;
    for (int unit = blockIdx.x; unit < 256 + NSB; unit += gridDim.x)
    for (int half = 0; half < (unit < 256 ? 2 : 1); ++half) {
        int row0, len, t0, sb = -1; bool islast;
        if (unit >= 256) { sb = unit - 256; row0 = TP + TSS * sb; len = TSS; t0 = 0; islast = true; }
        else { const int pi = 2 * unit + half; row0 = 32 * pi; len = 32; t0 = row0; islast = (pi == 511); }
        float* o_ca = a->out + (sb < 0 ? O_CAP + (size_t)l * 2 * DA : O_CAS + (size_t)(l * NSB + sb) * 2 * DA);
        float* o_cb = a->out + (sb < 0 ? O_CBP + (size_t)l * 3 * DB : O_CBS + (size_t)(l * NSB + sb) * 3 * DB);
        float* o_h  = a->out + (sb < 0 ? O_HP + (size_t)l * DB : O_HS + (size_t)(l * NSB + sb) * DB);
        float* o_cc = a->out + (sb < 0 ? O_CCP + (size_t)l * 30 * DC : O_CCS + (size_t)(l * NSB + sb) * 30 * DC);
        if (sb < 0 && t0 >= 30) {
            u32x2 cvr[8], cgr[8];
#pragma unroll
            for (int u = 0; u < 8; ++u) { const int e = tid + NTHR * u;
                if (e < 62 * 64) { const bf16_t* ur = U + (size_t)(row0 - 30 + (e >> 6)) * DIN + 4 * (e & 63); cvr[u] = *(const u32x2*)(ur + COL_CV); cgr[u] = *(const u32x2*)(ur + COL_CG); } }
#pragma unroll
            for (int u = 0; u < 8; ++u) { const int e = tid + NTHR * u;
                if (e < 62 * 64) { f32x4 v; v[0] = bflo(cvr[u].x) * sigm(bflo(cgr[u].x)); v[1] = bfhi(cvr[u].x) * sigm(bfhi(cgr[u].x)); v[2] = bflo(cvr[u].y) * sigm(bflo(cgr[u].y)); v[3] = bfhi(cvr[u].y) * sigm(bfhi(cgr[u].y));
                    *(LAS f32x4*)(vs + 4 * e) = v; } }
        } else
        for (int e = tid; e < (len + 30) * 64; e += NTHR) {
            const int i = e >> 6, q = e & 63, tt = t0 - 30 + i;
            f32x4 v = (f32x4){0.f, 0.f, 0.f, 0.f};
            if (tt >= 0) {
                const bf16_t* ur = U + (size_t)(row0 - 30 + i) * DIN;
                const f32x4 cv = ld_bf4(ur + COL_CV + 4 * q), cg_ = ld_bf4(ur + COL_CG + 4 * q);
#pragma unroll
                for (int z = 0; z < 4; ++z) v[z] = cv[z] * sigm(cg_[z]);
            } else if (sb >= 0) v = *(const f32x4*)(a->in[I_SC] + ((size_t)(l * NSB + sb) * 30 + (30 + tt)) * DC + 4 * q);
            *(LAS f32x4*)(vs + i * 256 + 4 * q) = v;
        }
        if (half == 0) {
            float hc;
            if (sb >= 0) hc = a->in[I_SH][(size_t)(l * NSB + sb) * DB + tid];
            else { hc = 0.f; const int nch = unit;
                int k = 0;
                for (; k + 32 <= nch; k += 32) { float A[32], B[32];
#pragma unroll
                    for (int q = 0; q < 32; ++q) { A[q] = AGG[((size_t)(k + q) * 2) * DB + tid]; B[q] = AGG[((size_t)(k + q) * 2 + 1) * DB + tid]; }
#pragma unroll
                    for (int q = 0; q < 32; ++q) hc = A[q] * hc + B[q]; }
                for (; k + 4 <= nch; k += 4) { float A[4], B[4];
#pragma unroll
                    for (int q = 0; q < 4; ++q) { A[q] = AGG[((size_t)(k + q) * 2) * DB + tid]; B[q] = AGG[((size_t)(k + q) * 2 + 1) * DB + tid]; }
#pragma unroll
                    for (int q = 0; q < 4; ++q) hc = A[q] * hc + B[q]; }
                for (; k < nch; ++k) { const float A = AGG[((size_t)k * 2) * DB + tid], B = AGG[((size_t)k * 2 + 1) * DB + tid]; hc = A * hc + B; } }
            carry[tid] = hc;
        }
        LDS_BARRIER();
        const int i0 = 4 * wave;
        if (i0 < len) {
            const int rb = row0 + i0, tb = t0 + i0;
            const bf16_t* ub = U + (size_t)rb * DIN;
            f32x4 acc[4];
#pragma unroll
            for (int j = 0; j < 4; ++j) acc[j] = *(const f32x4*)bccp;
            {
                const f32x4 z4 = (f32x4){0.f, 0.f, 0.f, 0.f};
                f32x4 pw1 = z4, pw2 = z4, pw3 = z4;
#pragma unroll 1
                for (int q = 0; q < 8; ++q) {
                    const LAS float* wp = wcs + (4 * q) * 256 + c4; const LAS float* vp = vs + (i0 + 4 * q) * 256 + c4;
                    const f32x4 w0 = *(const LAS f32x4*)(wp), w1 = *(const LAS f32x4*)(wp + 256), w2 = *(const LAS f32x4*)(wp + 512), w3 = q < 7 ? *(const LAS f32x4*)(wp + 768) : z4;
                    const f32x4 v0 = *(const LAS f32x4*)(vp), v1 = *(const LAS f32x4*)(vp + 256), v2 = *(const LAS f32x4*)(vp + 512), v3 = *(const LAS f32x4*)(vp + 768);
                    acc[0] += w0 * v0; acc[1] += pw3 * v0; acc[2] += pw2 * v0; acc[3] += pw1 * v0;
                    acc[0] += w1 * v1; acc[1] += w0 * v1;  acc[2] += pw3 * v1; acc[3] += pw2 * v1;
                    acc[0] += w2 * v2; acc[1] += w1 * v2;  acc[2] += w0 * v2;  acc[3] += pw3 * v2;
                    acc[0] += w3 * v3; acc[1] += w2 * v3;  acc[2] += w1 * v3;  acc[3] += w0 * v3;
                    pw1 = w1; pw2 = w2; pw3 = w3;
                }
                const f32x4 v32 = *(const LAS f32x4*)(vs + (i0 + 32) * 256 + c4), v33 = *(const LAS f32x4*)(vs + (i0 + 33) * 256 + c4);
                acc[2] += pw2 * v32; acc[3] += pw1 * v32; acc[3] += pw2 * v33;
            }
            f32x4 pr[6];
#pragma unroll
            for (int m = 0; m < 6; ++m) {
                const int tq = tb - 2 + m;
                if (tq >= 0) { const bf16_t* uq = U + (size_t)(rb - 2 + m) * DIN; pr[m] = ld_bf4(uq + COL_AC + c4) * ld_bf4(uq + COL_AX + c4); }
                else if (sb >= 0) pr[m] = *(const f32x4*)(a->in[I_SA] + ((size_t)(l * NSB + sb) * 2 + (2 + tq)) * DA + c4);
                else pr[m] = (f32x4){0.f, 0.f, 0.f, 0.f};
            }
            u32x2 abr[4];
#pragma unroll
            for (int j = 0; j < 4; ++j) abr[j] = *(const u32x2*)(ub + (size_t)j * DIN + COL_AB + c4);
            u32x4 ha0[4], ha1[4], bgr[4];
#pragma unroll
            for (int j = 0; j < 4; ++j) { ha0[j] = *(const u32x4*)(HLAC + (size_t)(rb + j) * DB + c8); ha1[j] = *(const u32x4*)(HLAC + (size_t)(rb + j) * DB + c8 + 4);
                bgr[j] = *(const u32x4*)(ub + (size_t)j * DIN + COL_BG + c8); }
            f32x4 ya[4], y0[4], y1[4];
            const f32x4 wa0 = *(const f32x4*)wap, wa1 = *(const f32x4*)(wap + DA), wa2 = *(const f32x4*)(wap + 2 * DA);
#pragma unroll
            for (int j = 0; j < 4; ++j) {
                ya[j] = (f32x4){bflo(abr[j].x), bfhi(abr[j].x), bflo(abr[j].y), bfhi(abr[j].y)} * (wa0 * pr[j] + wa1 * pr[j + 1] + wa2 * pr[j + 2]);
                const f32x4 hl0 = (f32x4){bflo(ha0[j].x), bflo(ha0[j].y), bflo(ha0[j].z), bflo(ha0[j].w)}, hl1 = (f32x4){bflo(ha1[j].x), bflo(ha1[j].y), bflo(ha1[j].z), bflo(ha1[j].w)};
                const f32x4 ac0 = (f32x4){bfhi(ha0[j].x), bfhi(ha0[j].y), bfhi(ha0[j].z), bfhi(ha0[j].w)}, ac1 = (f32x4){bfhi(ha1[j].x), bfhi(ha1[j].y), bfhi(ha1[j].z), bfhi(ha1[j].w)};
                const f32x4 h0 = hl0 + ac0 * *(const LAS f32x4*)(carry + c8), h1 = hl1 + ac1 * *(const LAS f32x4*)(carry + c8 + 4);
                const f32x4 g0 = (f32x4){bflo(bgr[j].x), bfhi(bgr[j].x), bflo(bgr[j].y), bfhi(bgr[j].y)}, g1 = (f32x4){bflo(bgr[j].z), bfhi(bgr[j].z), bflo(bgr[j].w), bfhi(bgr[j].w)};
#pragma unroll
                for (int z = 0; z < 4; ++z) { y0[j][z] = h0[z] * gelu_tanh(g0[z]); y1[j][z] = h1[z] * gelu_tanh(g1[z]); }
                if (islast && i0 + j == len - 1) { *(f32x4*)(o_h + c8) = h0; *(f32x4*)(o_h + c8 + 4) = h1; }
            }
            float sC[4], qC[4], qA[4], qB[4];
#pragma unroll
            for (int j = 0; j < 4; ++j) { sC[j] = hsum4(acc[j]); qC[j] = hsq4(acc[j]); qA[j] = hsq4(ya[j]); qB[j] = hsq4(y0[j]) + hsq4(y1[j]); }
#pragma unroll
            for (int hh = 0; hh < 2; ++hh) {
#pragma unroll
                for (int o = 1; o < 64; o <<= 1) { const int idx = (lane ^ o) << 2;
                    float t1[2], t2[2], t3[2], t4[2];
#pragma unroll
                    for (int j = 0; j < 2; ++j) { const int jj = 2 * hh + j;
                        t1[j] = __builtin_bit_cast(float, __builtin_amdgcn_ds_bpermute(idx, __builtin_bit_cast(int, sC[jj]))); t2[j] = __builtin_bit_cast(float, __builtin_amdgcn_ds_bpermute(idx, __builtin_bit_cast(int, qC[jj])));
                        t3[j] = __builtin_bit_cast(float, __builtin_amdgcn_ds_bpermute(idx, __builtin_bit_cast(int, qA[jj]))); t4[j] = __builtin_bit_cast(float, __builtin_amdgcn_ds_bpermute(idx, __builtin_bit_cast(int, qB[jj]))); }
#pragma unroll
                    for (int j = 0; j < 2; ++j) { const int jj = 2 * hh + j; sC[jj] += t1[j]; qC[jj] += t2[j]; qA[jj] += t3[j]; qB[jj] += t4[j]; } }
            }
            float qY[4];
            const f32x4 lng = *(const f32x4*)lngp, lnb = *(const f32x4*)lnbp;
#pragma unroll
            for (int j = 0; j < 4; ++j) {
                const float mu = sC[j] * (1.0f / DC), var = fmaxf(qC[j] * (1.0f / DC) - mu * mu, 0.f);
                f32x4 y = (acc[j] - mu) * __builtin_amdgcn_rsqf(var + EPS) * lng + lnb;
#pragma unroll
                for (int z = 0; z < 4; ++z) y[z] = y[z] * sigm(y[z]);
                acc[j] = y; qY[j] = hsq4(y);
            }
            wave_sum4_l(qY[0], qY[1], qY[2], qY[3], lane);
            const f32x4 gA = *(const f32x4*)(grp + c4), gC = *(const f32x4*)(grp + 768 + c4), gB0 = *(const f32x4*)(grp + 256 + c8), gB1 = *(const f32x4*)(grp + 256 + c8 + 4);
#pragma unroll
            for (int j = 0; j < 4; ++j) {
                const int i = i0 + j;
                bf16_t* yr = Y + (size_t)(rb + j) * D;
                { const f32x4 y = acc[j] * (__builtin_amdgcn_rsqf(qY[j] * (1.0f / DC) + EPS)) * gC; u32x2 o; o.x = pk2(y[0], y[1]); o.y = pk2(y[2], y[3]); *(u32x2*)(yr + 768 + c4) = o; }
                { const f32x4 y = ya[j] * (__builtin_amdgcn_rsqf(qA[j] * (1.0f / DA) + EPS)) * gA; u32x2 o; o.x = pk2(y[0], y[1]); o.y = pk2(y[2], y[3]); *(u32x2*)(yr + c4) = o; }
                { const float rs = __builtin_amdgcn_rsqf(qB[j] * (1.0f / DB) + EPS); const f32x4 a0 = y0[j] * rs * gB0, a1 = y1[j] * rs * gB1;
                  u32x4 o; o.x = pk2(a0[0], a0[1]); o.y = pk2(a0[2], a0[3]); o.z = pk2(a1[0], a1[1]); o.w = pk2(a1[2], a1[3]); *(u32x4*)(yr + 256 + c8) = o; }
                if (islast) {
                    if (i >= len - 2) *(f32x4*)(o_ca + (size_t)(i - (len - 2)) * DA + c4) = pr[j + 2];
                    if (i >= len - 3) { const bf16_t* ur = ub + (size_t)j * DIN; float* ob = o_cb + (size_t)(i - (len - 3)) * DB + c8; *(f32x4*)ob = ld_bf4(ur + COL_BX + c8); *(f32x4*)(ob + 4) = ld_bf4(ur + COL_BX + c8 + 4); }
                }
            }
        }
        if (islast) {
            for (int e = tid; e < 30 * 64; e += NTHR) { const int i = e >> 6, q = e & 63; *(f32x4*)(o_cc + (size_t)i * DC + 4 * q) = *(const LAS f32x4*)(vs + (len + i) * 256 + 4 * q); }
        }
        LDS_BARRIER();
    }
}

#define XB_TMO      128
#define XB_XCNT(j)  (256  + 64 * (j))
#define XB_XSUB(j)  (1280 + 64 * (j))
#define XB_XGEN(j)  (2304 + 64 * (j))
#define XB_TOP      3328
#define XB_TOPGEN   3392
#define XCD_BAR_WORDS 3456
#define XB_SPIN_CAP (1u << 18)

__device__ __forceinline__ unsigned xb_ld(unsigned* p)              { return __hip_atomic_load(p, __ATOMIC_RELAXED, __HIP_MEMORY_SCOPE_AGENT); }
__device__ __forceinline__ unsigned xb_add(unsigned* p, unsigned v) { return __hip_atomic_fetch_add(p, v, __ATOMIC_RELAXED, __HIP_MEMORY_SCOPE_AGENT); }
__device__ __forceinline__ unsigned xb_xcc_id() { return (unsigned)__builtin_amdgcn_s_getreg((3 << 11) | 20) & 0xFu; }
#define XB_SPIN(cond, bar) do { unsigned _sp = 0; while (cond) { __builtin_amdgcn_s_sleep(1); \
    if ((++_sp & 255u) == 0u) { if (xb_ld(&(bar)[XB_TMO])) break; if (_sp > XB_SPIN_CAP) { atomicAdd(&(bar)[XB_TMO], 1u); break; } } } } while (0)

struct XcdBarrier {
    unsigned* bar; unsigned x;
    volatile LAS unsigned* st;
};

__device__ __forceinline__ XcdBarrier xcd_barrier_post(unsigned* bar, volatile LAS unsigned* st) {
    XcdBarrier b; b.bar = bar; b.x = xb_xcc_id(); b.st = st;
    if (threadIdx.x == 0) (void)xb_add(&bar[XB_XCNT(b.x)], 1u);
    return b;
}
__device__ __forceinline__ void xcd_barrier_complete(unsigned* bar, unsigned x, unsigned& nloc, unsigned& nx) {
    const unsigned G = gridDim.x * gridDim.y * gridDim.z;
    unsigned sum, cnt, mine, sp = 0u;
    for (;;) {
        sum = 0u; cnt = 0u; mine = 0u;
#pragma unroll
        for (unsigned j = 0; j < 16; ++j) { const unsigned c = xb_ld(&bar[XB_XCNT(j)]); sum += c; cnt += (c > 0u) ? 1u : 0u; mine = (j == x) ? c : mine; }
        if (sum == G) break;
        __builtin_amdgcn_s_sleep(1);
        if ((++sp & 255u) == 0u) { if (xb_ld(&bar[XB_TMO])) break; if (sp > XB_SPIN_CAP) { atomicAdd(&bar[XB_TMO], 1u); break; } }
    }
    nloc = mine > 0u ? mine : 1u; nx = cnt > 0u ? cnt : 1u;
}

__device__ __forceinline__ void xcd_barrier(const XcdBarrier& b) {
    asm volatile("s_waitcnt vmcnt(0)" ::: "memory");
    __syncthreads();
    if (threadIdx.x == 0) {
        unsigned* bar = b.bar;
        __builtin_amdgcn_s_waitcnt(0);
        unsigned nloc = b.st[0], nx = b.st[1];
        if (nloc == 0u) { xcd_barrier_complete(bar, b.x, nloc, nx); b.st[0] = nloc; b.st[1] = nx; }
        const unsigned old = xb_add(&bar[XB_XSUB(b.x)], 1u);
        const unsigned gen = old / nloc;
        if (old + 1u == (gen + 1u) * nloc) {
            __builtin_amdgcn_fence(__ATOMIC_RELEASE, "agent");
            asm volatile("s_waitcnt vmcnt(0)" ::: "memory");
            const unsigned og = xb_add(&bar[XB_TOP], 1u);
            const unsigned tg = og / nx;
            if (og + 1u == (tg + 1u) * nx) xb_add(&bar[XB_TOPGEN], 1u);
            else XB_SPIN(xb_ld(&bar[XB_TOPGEN]) == tg, bar);
            __builtin_amdgcn_fence(__ATOMIC_ACQUIRE, "agent");
            xb_add(&bar[XB_XGEN(b.x)], 1u);
            asm volatile("s_waitcnt vmcnt(0)" ::: "memory");
        } else {
            XB_SPIN(xb_ld(&bar[XB_XGEN(b.x)]) == gen, bar);
            __builtin_amdgcn_fence(__ATOMIC_ACQUIRE, "agent");
            asm volatile("s_waitcnt vmcnt(0)" ::: "memory");
        }
    }
    __syncthreads();
}

__global__ void __launch_bounds__(NTHR, 2) fwd_kernel(Args a_val) {
    extern __shared__ __attribute__((aligned(16))) unsigned char lds_raw[];
    LAS unsigned char* lds = (LAS unsigned char*)lds_raw;
    unsigned char* ws = a_val.ws;
    volatile LAS unsigned* bst = (volatile LAS unsigned*)(lds + 131072 + 64);
    if (threadIdx.x < 3) bst[threadIdx.x] = 0u;
    __syncthreads();
    const XcdBarrier bar = xcd_barrier_post((unsigned*)ws, bst);
    if (threadIdx.x == 0) { const unsigned x = xb_xcc_id();
        if (x != ((unsigned)blockIdx.x & 7u)) __hip_atomic_fetch_add((unsigned*)(ws + 14336), 1u, __ATOMIC_RELAXED, __HIP_MEMORY_SCOPE_AGENT);
        if (x != (((unsigned)blockIdx.x >> 5) & 7u)) __hip_atomic_fetch_add((unsigned*)(ws + 14336 + 256), 1u, __ATOMIC_RELAXED, __HIP_MEMORY_SCOPE_AGENT); }
    const float* mod = (const float*)(ws + WS_MOD);
    const int G = gridDim.x;
    for (int step = a_val.ph_lo; step < a_val.ph_hi; ++step) {
        if (step == a_val.ph_lo + 1) {
            if (threadIdx.x == 0) { const unsigned m1 = __hip_atomic_load((unsigned*)(a_val.ws + 14336), __ATOMIC_RELAXED, __HIP_MEMORY_SCOPE_AGENT), m2 = __hip_atomic_load((unsigned*)(a_val.ws + 14336 + 256), __ATOMIC_RELAXED, __HIP_MEMORY_SCOPE_AGENT);
                bst[2] = (gridDim.x == 256 && m2 < m1) ? 1u : 0u; }
            __syncthreads();
        }
        int ph = step;
#if MK_PROBE == 4
        ph = step == 0 ? 0 : step - 1;
#elif MK_PROBE == 2 || MK_PROBE == 3 || MK_PROBE == 5 || MK_PROBE == 6
        if (step >= 2) {
            constexpr unsigned long long TAB = MK_PROBE == 2 ? 0xA98765443210ull : MK_PROBE == 3 ? 0xA98765543210ull : MK_PROBE == 5 ? 0xA9887654332100ull : 0xA9987665432110ull;
            constexpr int LSTEPS = (MK_PROBE == 2 || MK_PROBE == 3) ? 12 : 14;
            const int ls = (step - 2) / LSTEPS, s = (step - 2) % LSTEPS;
            ph = 2 + 11 * ls + (int)((TAB >> (4 * s)) & 15ull);
        }
#endif
        CArgs a = (CArgs)__builtin_amdgcn_kernarg_segment_ptr(); asm volatile("" : "+s"(a));
        int tid = threadIdx.x; asm volatile("" : "+v"(tid));
        const int lane = tid & 63, wave = __builtin_amdgcn_readfirstlane(tid >> 6);
        if (ph == 0) { if (!MK_NO_PRO) phase_prologue(a, lds, tid, lane, wave); }
        else if (ph == 1) phase_rows(a, lane, wave, 0, false, 0.f, 1, mod, 0, a->in[I_NPOST], mod, 1, 0, a->in[I_NPRE]);
        else {
            const int l = (ph - 2) / 11, k = (ph - 2) % 11;
            const float* modl = mod + (size_t)l * 9 * 9216;
            const bool defer_win = (G == 256) && MK_DEFER_WIN;
            if (k == 0 || k == 8 || k == 1 || k == 9 || k == 6 || k == 3 || (k == 4 && defer_win)) {
                pg8::Gemm g; pg8::EpiMulti E; int N;
                const int cv = __builtin_amdgcn_readfirstlane(bst[2] ? (int)((blockIdx.x & 31u) * 8u + (blockIdx.x >> 5)) : (int)blockIdx.x);
                const bool n1024 = (k == 1 || k == 6 || k == 9);
                if (k == 0 || k == 8) {
                    g = pg8::Gemm{(const bf16_t*)(ws + WS_H), (const bf16_t*)(ws + WS_W13 + (size_t)(l * 2 + (k == 0 ? 0 : 1)) * W13_BYTES), MP, 2 * DFF, D, D};
                    E = pg8::EpiMulti{0, (void*)(ws + WS_GU), DFF}; N = 2 * DFF;
                } else if (k == 6) {
                    g = pg8::Gemm{(const bf16_t*)(ws + WS_Y), (const bf16_t*)(ws + WS_WOUT + (size_t)l * WOUT_BYTES), MP, D, D, D};
                    E = pg8::EpiMulti{2, (void*)(ws + WS_F), D}; N = D;
                } else if (k == 3 || k == 4) {
                    g = pg8::Gemm{(const bf16_t*)(ws + WS_H), (const bf16_t*)(ws + WS_WIN + (size_t)l * WIN_BYTES), MP, DIN, D, D};
                    E = pg8::EpiMulti{2, (void*)(ws + WS_GU), DIN}; N = DIN;
                } else {
                    g = pg8::Gemm{(const bf16_t*)(ws + WS_GU), (const bf16_t*)(ws + WS_W2 + (size_t)(l * 2 + (k == 1 ? 0 : 1)) * W2_BYTES), MP, D, DFF, DFF};
                    E = pg8::EpiMulti{2, (void*)(ws + WS_F), D}; N = D;
                }
                const int nparts = n1024 ? 2 : 1;
                for (int part = 0; part < nparts; ++part) {
                    pg8::StaticOrder S;
                    if (k == 3 && defer_win) { S.init(MP, 7 * 256, G, cv); S.mode = 1; }
                    else if (k == 4) { S.init(MP, N, G, (int)blockIdx.x - 176); S.mode = 2; }
                    else if (!n1024) S.init(MP, N, G, cv);
                    else if (part == 0) S.init(TP, N, G, cv);
                    else { S.init(256, N, G, cv, TP / 256, g.ld / 256, 256); g.K = 256; E = pg8::EpiMulti{4, (void*)(ws + WS_FPART), D}; }
                    if (!MK_NO_G1) pg8::gemm_phase<pg8::EpiMulti, pg8::StaticOrder, true, true>(lds, g, S, E);
                }
            }
            if (k == 4) { if (!MK_NO_MIX1) phase_mix1(a, lds, l, tid, lane, wave, defer_win); }
            else if (k == 0 || k == 8 || k == 1 || k == 9 || k == 6 || k == 3) { }
            else if (k == 5) { if (!MK_NO_MIX2) phase_mix2(a, lds, l, tid, lane, wave); }
            else {
                const int sub = k == 2 ? 0 : (k == 7 ? 1 : 2);
                const bool fin = (k == 10 && l == NL - 1);
                const int ln = k == 10 ? (l + 1 < NL ? l + 1 : l) : l, subn = k == 10 ? 0 : sub + 1;
                phase_rows(a, lane, wave, 1, fin, sub == 1 ? 1.0f : 0.5f, sub == 1 ? D / 256 : DFF / 256, modl, 3 * sub + 2, a->in[I_NPOST] + (size_t)(l * 3 + sub) * D,
                           mod + (size_t)ln * 9 * 9216, 3 * subn + 1, 3 * subn, a->in[I_NPRE] + (size_t)(ln * 3 + subn) * D);
            }
        }
        if (step + 1 < a_val.ph_hi) xcd_barrier(bar);
#if MK_PROBE == 1
        if (step + 1 < a_val.ph_hi) xcd_barrier(bar);
#endif
        if (a_val.ph_hi == -12345) cg::this_grid().sync();
    }
}

#if MK_CHECK
__device__ __forceinline__ float wsum(float v) { for (int o = 32; o > 0; o >>= 1) v += __shfl_xor(v, o); return v; }
__device__ __forceinline__ float bfv(const bf16_t* p) { return __builtin_bit_cast(float, (unsigned)(*p) << 16); }
__device__ __forceinline__ bool isbad(float got, float ref, float rel, float ab) { const float d = fabsf(got - ref); return !(d <= ab + rel * fabsf(ref)); }
__device__ __forceinline__ void fail(unsigned* w, unsigned code) { atomicMin(w, code); }
__device__ float dotA(const bf16_t* Arow, const float* W, int K, int N, int c, int lane) { float s = 0.f; for (int k = lane; k < K; k += 64) s += bfv(Arow + k) * W[(size_t)k * N + c]; return wsum(s); }
__device__ int chk_row(int i) { const int R[6] = {0, 300, 16383, 16384, 16400, 16511}; return i == 0 ? 0 : i == 1 ? 300 : i == 2 ? 16383 : i == 3 ? 16384 : i == 4 ? 16400 : 16511; }
__global__ void chk_kernel(Args a, int stage) {
    const int lane = threadIdx.x, s = blockIdx.x;
    unsigned char* ws = a.ws; unsigned* word = (unsigned*)(ws + 32768);
    const float* mod = (const float*)(ws + WS_MOD);
    const float* Xb = (const float*)(ws + WS_X); const bf16_t* H = (const bf16_t*)(ws + WS_H); const bf16_t* Fb = (const bf16_t*)(ws + WS_F);
    const bf16_t* GU = (const bf16_t*)(ws + WS_GU); const bf16_t* Y = (const bf16_t*)(ws + WS_Y);
    const int r = chk_row(s % 6), bidx = r < TP ? 0 : 1 + ((r - TP) >> 4);
    const int cs = s / 6;
    if (stage == 1) {
        { const int b = (s * 3) % 9, n = (s * 1531 + 7) % 9216; float acc = 0.f;
          for (int k = lane; k < 1024; k += 64) { const float c = b == 0 ? a.in[I_CP][k] : a.in[I_CS][(b - 1) * 1024 + k]; acc += c / (1.f + expf(-c)) * a.in[I_WADA][(size_t)k * 9216 + n]; }
          acc = wsum(acc) + a.in[I_BADA][n];
          const float got = mod[(size_t)b * 9216 + n], d = fabsf(got - acc);
          if (isbad(got, acc, 1e-3f, 1e-3f)) fail(word, 1); }
        { const int c = (s * 401 + 130) % DFF, row = (c >> 7) * 256 + (c & 127); const bf16_t* WT = (const bf16_t*)(ws + WS_W13);
          for (int k = lane; k < 1024; k += 64) { if (isbad(bfv(WT + (size_t)row * 1024 + k), a.in[I_W1][(size_t)k * DFF + c], 0.01f, 1e-6f)) fail(word, 2);
                                                  if (isbad(bfv(WT + (size_t)(row + 128) * 1024 + k), a.in[I_W3][(size_t)k * DFF + c], 0.01f, 1e-6f)) fail(word, 3); } }
        { const int c = (s * 211 + 513) % D; const bf16_t* WT = (const bf16_t*)(ws + WS_W2);
          for (int k = lane; k < DFF; k += 64) if (isbad(bfv(WT + (size_t)c * DFF + k), a.in[I_W2][(size_t)k * D + c], 0.01f, 1e-6f)) fail(word, 4); }
        { const int c = (s * 577 + 2303) % DIN; const bf16_t* WT = (const bf16_t*)(ws + WS_WIN);
          for (int k = lane; k < D; k += 64) if (isbad(bfv(WT + (size_t)c * D + k), a.in[I_WIN][(size_t)k * DIN + c], 0.01f, 1e-6f)) fail(word, 5); }
        { const int c = (s * 311 + 1023) % D; const bf16_t* WT = (const bf16_t*)(ws + WS_WOUT);
          for (int k = lane; k < D; k += 64) if (isbad(bfv(WT + (size_t)c * D + k), a.in[I_WOUT][(size_t)k * D + c], 0.01f, 1e-6f)) fail(word, 6); }
        { const int c = (s * 401 + 130) % DFF, row = (c >> 7) * 256 + (c & 127); const bf16_t* WT = (const bf16_t*)(ws + WS_W13 + 7 * W13_BYTES);
          for (int k = lane; k < 1024; k += 64) if (isbad(bfv(WT + (size_t)(row + 128) * 1024 + k), a.in[I_W3][(size_t)7 * D * DFF + (size_t)k * DFF + c], 0.01f, 1e-6f)) fail(word, 7); }
    } else if (stage == 2 || stage == 5 || stage == 9) {
        const float* xin = r < TP ? a.in[I_XP] + (size_t)r * D : a.in[I_XS] + (size_t)(r - TP) * D;
        float ssx = 0.f;
        for (int c = lane; c < D; c += 64) ssx += Xb[(size_t)r * D + c] * Xb[(size_t)r * D + c];
        const float rstdx = 1.f / sqrtf(wsum(ssx) / D + EPS);
        if (stage == 2) { for (int c = lane; c < D; c += 64) if (isbad(Xb[(size_t)r * D + c], xin[c], 1e-6f, 1e-6f)) fail(word, 8); }
        if (stage == 5) { float ssf = 0.f; for (int c = lane; c < D; c += 64) { const float f = bfv(Fb + (size_t)r * D + c); ssf += f * f; }
            const float rstdf = 1.f / sqrtf(wsum(ssf) / D + EPS);
            for (int c = lane; c < D; c += 64) { const float ref = xin[c] + 0.5f * mod[((size_t)bidx * 9 + 2) * D + c] * bfv(Fb + (size_t)r * D + c) * rstdf * a.in[I_NPOST][c];
                if (isbad(Xb[(size_t)r * D + c], ref, 1e-3f, 1e-3f)) fail(word, 11); } }
        const int sub = stage == 2 ? 0 : (stage == 5 ? 1 : 2);
        for (int c = lane; c < D; c += 64) { const float ref = Xb[(size_t)r * D + c] * rstdx * a.in[I_NPRE][sub * D + c] * (1.f + mod[((size_t)bidx * 9 + 3 * sub + 1) * D + c]) + mod[((size_t)bidx * 9 + 3 * sub) * D + c];
            if (isbad(bfv(H + (size_t)r * D + c), ref, 0.01f, 0.01f)) fail(word, stage == 2 ? 9 : (stage == 5 ? 12 : 24)); }
    } else if (stage == 3) {
        const int c = (cs * 937 + 130 * (s % 6)) % DFF;
        const float a1 = dotA(H + (size_t)r * D, a.in[I_W1], D, DFF, c, lane), a3 = dotA(H + (size_t)r * D, a.in[I_W3], D, DFF, c, lane);
        const float ref = a1 / (1.f + expf(-a1)) * a3;
        if (isbad(bfv(GU + (size_t)r * DFF + c), ref, 0.03f, 0.03f)) fail(word, 10);
    } else if (stage == 4) {
        const int c = (cs * 341 + 513 * (s % 6)) % D;
        const float ref = dotA(GU + (size_t)r * DFF, a.in[I_W2], DFF, D, c, lane);
        if (isbad(bfv(Fb + (size_t)r * D + c), ref, 0.03f, 0.03f)) fail(word, 13);
    } else if (stage == 6) {
        const int c = (cs * 601 + 255 * (s % 6) + 1) % DIN;
        const float ref = dotA(H + (size_t)r * D, a.in[I_WIN], D, DIN, c, lane);
        if (isbad(bfv(GU + (size_t)r * DIN + c), ref, 0.03f, 0.03f)) fail(word, 14);
    } else if (stage == 8) {
        const int c = (cs * 341 + 513 * (s % 6)) % D;
        const float ref = dotA(Y + (size_t)r * D, a.in[I_WOUT], D, D, c, lane);
        if (isbad(bfv(Fb + (size_t)r * D + c), ref, 0.03f, 0.03f)) fail(word, 23);
    } else if (stage == 7) {
        if (s < 6) {
            const bool smp = s >= 3; const int sbb = s - 3;
            const int rl = smp ? TP + 16 * sbb + 15 : TP - 1;
            for (int c = lane; c < DA; c += 64) { const bf16_t* u = GU + (size_t)rl * DIN; const float ref = bfv(u + COL_AC + c) * bfv(u + COL_AX + c);
                const float got = a.out[(smp ? O_CAS + (size_t)sbb * 2 * DA : O_CAP) + DA + c]; if (isbad(got, ref, 1e-3f, 1e-4f)) fail(word, 15); }
            for (int c = lane; c < DB; c += 64) { const float ref = bfv(GU + (size_t)(rl - 2) * DIN + COL_BX + c);
                const float got = a.out[(smp ? O_CBS + (size_t)sbb * 3 * DB : O_CBP) + c]; if (isbad(got, ref, 1e-3f, 1e-4f)) fail(word, 16); }
            for (int c = lane; c < DC; c += 64) { const bf16_t* u = GU + (size_t)(rl - 3) * DIN; const float ref = bfv(u + COL_CV + c) / (1.f + expf(-bfv(u + COL_CG + c)));
                const float got = a.out[(smp ? O_CCS + (size_t)sbb * 30 * DC : O_CCP) + 26 * DC + c]; if (isbad(got, ref, 2e-3f, 1e-4f)) fail(word, 17); }
            if (smp) { for (int c = lane; c < DC; c += 64) { const float ref = a.in[I_SC][((size_t)sbb * 30 + 20) * DC + c];
                const float got = a.out[O_CCS + (size_t)sbb * 30 * DC + 4 * DC + c]; if (isbad(got, ref, 1e-5f, 1e-6f)) fail(word, 18); } }
        } else if (s < 12) {
            const int which = s - 6; const bool smp = which >= 3; const int sbb = which - 3;
            const int ch = (which * 97 + 5) % DB, head = ch >> 6, ci = 64 * head + lane;
            const int T = smp ? 16 : TP, rbase = smp ? TP + 16 * sbb : 0;
            float h = smp ? a.in[I_SH][(size_t)sbb * DB + ch] : 0.f;
            const float wrl = a.in[I_WGR][((size_t)head * 64 + lane) * 64 + (ch & 63)], wil = a.in[I_WGI][((size_t)head * 64 + lane) * 64 + (ch & 63)];
            const float lam = a.in[I_LAM][ch], lsg = -log1pf(expf(-lam));
            float xm3, xm2, xm1;
            if (smp) { xm3 = a.in[I_SB][((size_t)sbb * 3 + 0) * DB + ci]; xm2 = a.in[I_SB][((size_t)sbb * 3 + 1) * DB + ci]; xm1 = a.in[I_SB][((size_t)sbb * 3 + 2) * DB + ci]; } else { xm3 = xm2 = xm1 = 0.f; }
            const float w0 = a.in[I_WCB][0 * DB + ci], w1 = a.in[I_WCB][1 * DB + ci], w2 = a.in[I_WCB][2 * DB + ci], w3 = a.in[I_WCB][3 * DB + ci], bc = a.in[I_BCB][ci];
            float h100 = 0.f, h63 = 0.f;
            for (int t = 0; t < T; ++t) {
                const float x0 = bfv(GU + (size_t)(rbase + t) * DIN + COL_BX + ci);
                const float xb = bc + w0 * xm3 + w1 * xm2 + w2 * xm1 + w3 * x0; xm3 = xm2; xm2 = xm1; xm1 = x0;
                const float rp = wsum(xb * wrl) + a.in[I_BGR][ch], ip = wsum(xb * wil) + a.in[I_BGI][ch];
                const float xbc = __shfl(xb, ch & 63);
                const float rr = 1.f / (1.f + expf(-rp)), ii = 1.f / (1.f + expf(-ip));
                const float la = 8.f * rr * lsg, av = expf(la);
                h = av * h + sqrtf(-expm1f(2.f * la)) * ii * xbc;
                if (t == 63) h63 = h; if (t == 100) h100 = h;
            }
            const float got = a.out[(smp ? O_HS + (size_t)sbb * DB : O_HP) + ch];
            if (isbad(got, h, 0.02f, 0.003f)) fail(word, smp ? 19 : 20);
            if (!smp) { const float* HL = (const float*)(ws + WS_HL); const float* AC = (const float*)(ws + WS_AC);
                if (isbad(HL[(size_t)63 * DB + ch], h63, 0.01f, 0.002f)) fail(word, 21);
                if (isbad(HL[(size_t)100 * DB + ch] + AC[(size_t)100 * DB + ch] * h63, h100, 0.01f, 0.002f)) fail(word, 22); }
        }
    }
}
__global__ void chk_report(Args a) { const unsigned w = *(unsigned*)(a.ws + 32768); if (w != 0x7f7f7f7fu) a.out[0] = 100.0f * (float)w; }
#endif
}

extern "C" void kernel_launch(void* const* d_in, const int* in_sizes, int n_in, void* d_out, int out_size, void* d_ws, size_t ws_size, hipStream_t stream) {
    using namespace mk;
    static int grid = 0;
    if (grid == 0) {
        if (n_in != 30 || (size_t)out_size != O_END || ws_size < WS_END) { fprintf(stderr, "kernel_launch: unexpected shapes (n_in %d out %d ws %zu)\n", n_in, out_size, ws_size); grid = -1; return; }
        int dev = 0, cus = 0, per_cu = 0;
        if (hipGetDevice(&dev) != hipSuccess || hipDeviceGetAttribute(&cus, hipDeviceAttributeMultiprocessorCount, dev) != hipSuccess) { grid = -1; return; }
        if (hipFuncSetAttribute((const void*)fwd_kernel, hipFuncAttributeMaxDynamicSharedMemorySize, LDS_BYTES) != hipSuccess) { fprintf(stderr, "kernel_launch: hipFuncSetAttribute failed\n"); grid = -1; return; }
        if (hipOccupancyMaxActiveBlocksPerMultiprocessor(&per_cu, (const void*)fwd_kernel, NTHR, LDS_BYTES) != hipSuccess || per_cu < 1) { fprintf(stderr, "kernel_launch: occupancy query gave %d\n", per_cu); per_cu = 1; }
        (void)hipGetLastError();
        grid = cus * 1;
    }
    if (grid < 0) return;
    if (hipMemsetAsync(d_ws, 0, 16384, stream) != hipSuccess) { fprintf(stderr, "kernel_launch: memset failed\n"); return; }
    Args a{};
    for (int i = 0; i < 30; ++i) a.in[i] = (const float*)d_in[i];
    a.out = (float*)d_out; a.ws = (unsigned char*)d_ws;
#if MK_ONE_LAUNCH
    a.ph_lo = 0; a.ph_hi = NSTEP;
    void* args[] = {&a};
    hipError_t e = hipLaunchCooperativeKernel((const void*)fwd_kernel, dim3(grid), dim3(NTHR), args, LDS_BYTES, stream);
    if (e != hipSuccess) fprintf(stderr, "kernel_launch: cooperative launch failed: %s (grid %d)\n", hipGetErrorString(e), grid);
#else
#if MK_CHECK
    hipMemsetAsync((char*)d_ws + 32768, 0x7f, 256, stream);
#endif
    for (int ph = 0; ph < NPH; ++ph) {
        a.ph_lo = ph; a.ph_hi = ph + 1;
        hipLaunchKernelGGL(fwd_kernel, dim3(grid), dim3(NTHR), LDS_BYTES, stream, a);
#if MK_CHECK
        const int stg = ph == 0 ? 1 : ph == 1 ? 2 : ph == 2 ? 3 : ph == 3 ? 4 : ph == 4 ? 5 : ph == 5 ? 6 : ph == 7 ? 7 : ph == 8 ? 8 : ph == 9 ? 9 : 0;
        if (stg) hipLaunchKernelGGL(chk_kernel, dim3(24), dim3(64), 0, stream, a, stg);
#endif
    }
#if MK_CHECK
    hipLaunchKernelGGL(chk_report, dim3(1), dim3(1), 0, stream, a);
#endif
#endif
}
```

```cpp
#include <hip/hip_runtime.h>
#include <hip/hip_cooperative_groups.h>
#include <cstdio>
#include <cstdint>
namespace cg = cooperative_groups;
namespace pg8 {
#define PG8_LAS __attribute__((address_space(3)))
typedef unsigned short bf16_t;
typedef short bf16x8 __attribute__((ext_vector_type(8)));
typedef float f32x4 __attribute__((ext_vector_type(4)));
typedef unsigned u32x4 __attribute__((ext_vector_type(4)));
constexpr int BM = 256, BK = 64, HALF = 128, HTB = HALF * BK * 2  , STAGE_BYTES = 8 * HTB, NXCD = 8, WGM = 8;

__host__ __device__ __forceinline__ int lds_byte(int r, int c) { const int st = (r >> 4) * 2 + (c >> 5), rr = r & 15, cc = c & 31, ob = rr * 64 + cc * 2; return st * 1024 + (ob ^ (((ob >> 9) & 1) << 5)); }
__host__ __device__ __forceinline__ void stage_rc(int b, int& R, int& C) { const int st = b / 1024, sb = b % 1024, swz = sb ^ (((sb >> 9) & 1) << 5); R = (st >> 1) * 16 + swz / 64; C = (st & 1) * 32 + (swz % 64) / 2; }
__host__ __device__ __forceinline__ int perm32(int rho) { const int n = rho >> 4, i = rho & 15; return 8 * (i >> 2) + 4 * n + (i & 3); }

struct Unit { int pm, pn, ko, nt, sp; };
struct Gemm { const bf16_t* A; const bf16_t* Bt; int M, N, K, ld; };

struct StaticOrder {
    int nM, nN, nwg, G, c, pm0, nsplit, klen, mode, pmx, xsplit;
    __host__ __device__ void init(int M, int N, int G_, int c_, int pm0_ = 0, int nsplit_ = 1, int klen_ = 0) { nM = M / BM; nN = N / BM; nwg = nM * nN; G = G_; c = c_; pm0 = pm0_; nsplit = nsplit_; klen = klen_; mode = 0; }
    __host__ __device__ bool next(int i, Unit& u) const {
        const long L = (long)i * G + c;
        if (mode == 3 && i >= 1) { if (i > 1 || c >= nN * xsplit) return false; u.pm = pmx; u.pn = c % nN; u.ko = (c / nN) * klen; u.nt = klen / BK; u.sp = 1; return true; }
        if (mode == 3) { if (L >= nwg) return false; }
        if (nsplit > 1) { if (L >= (long)nN * nsplit) return false; u.pm = pm0; u.pn = (int)(L % nN); u.ko = (int)(L / nN) * klen; u.nt = 0; u.sp = 1; return true; }
        if (mode == 2) { if (i > 0 || c < 0 || c >= 80) return false; if (c < 65) { u.pm = c; u.pn = 8; } else { u.pm = 50 + (c - 65); u.pn = 7; } u.ko = 0; u.nt = 0; u.sp = 0; return true; }
        if (mode == 1 && L >= nwg) { const long Lp = L - nwg; if (Lp >= 50) return false; u.pm = (int)Lp; u.pn = 7; u.ko = 0; u.nt = 0; u.sp = 0; return true; }
        if (L >= nwg) return false;
        int wgid = (int)L; { const int q = nwg / NXCD, r = nwg % NXCD, xcd = wgid % NXCD, off = wgid / NXCD; wgid = (xcd < r ? xcd * (q + 1) : r * (q + 1) + (xcd - r) * q) + off; }
        const int nig = WGM * nN, gid = wgid / nig, fm = gid * WGM, gsz = (nM - fm) < WGM ? (nM - fm) : WGM;
        u.pm = pm0 + fm + ((wgid % nig) % gsz); u.pn = (wgid % nig) / gsz; u.ko = 0; u.nt = 0; u.sp = 0; return true;
    }
    __device__ __forceinline__ void a_ready(const Unit&) const {}
    __device__ __forceinline__ void done(const Unit&) const {}
};

__device__ __forceinline__ unsigned cvt_pk_bf16(float lo, float hi) { unsigned r; asm volatile("v_cvt_pk_bf16_f32 %0, %1, %2" : "=v"(r) : "v"(lo), "v"(hi)); return r; }
typedef float f32x2 __attribute__((ext_vector_type(2)));
__device__ __forceinline__ float fast_sigmoid(float x) { return __builtin_amdgcn_rcpf(1.0f + __builtin_amdgcn_exp2f(-1.44269504089f * x)); }
struct EpiSwiGLU {
    static constexpr bool PERM = true, AFTER_DRAIN = false;
    bf16_t* O; int ldc;
    __device__ __forceinline__ void operator()(const f32x4 (&acc)[2][2][4][2], const Unit& u, int wr, int wc, int fr, int fq) const {
        const int row0 = u.pm * BM + wr * 64 + fr, col0 = u.pn * HALF + wc * 32 + 8 * fq;
#pragma unroll
        for (int ai = 0; ai < 2; ++ai)
#pragma unroll
            for (int m = 0; m < 4; ++m) {
                bf16_t* rowp = O + (size_t)(row0 + ai * HALF + m * 16) * ldc + col0;
                f32x4 g0, g1;
#pragma unroll
                for (int e = 0; e < 4; ++e) {
                    const float a0 = acc[ai][0][m][0][e], a1 = acc[ai][0][m][1][e];
                    g0[e] = a0 * fast_sigmoid(a0) * acc[ai][1][m][0][e];
                    g1[e] = a1 * fast_sigmoid(a1) * acc[ai][1][m][1][e];
                }
                u32x4 w; w.x = cvt_pk_bf16(g0[0], g0[1]); w.y = cvt_pk_bf16(g0[2], g0[3]); w.z = cvt_pk_bf16(g1[0], g1[1]); w.w = cvt_pk_bf16(g1[2], g1[3]);
                *(u32x4*)rowp = w;
            }
    }
};
struct EpiF32 {
    static constexpr bool PERM = true, AFTER_DRAIN = false;
    float* O; int ldc;
    __device__ __forceinline__ void operator()(const f32x4 (&acc)[2][2][4][2], const Unit& u, int wr, int wc, int fr, int fq) const {
        const int row0 = u.pm * BM + wr * 64 + fr, col0 = u.pn * BM + wc * 32 + 8 * fq;
#pragma unroll
        for (int ai = 0; ai < 2; ++ai)
#pragma unroll
            for (int m = 0; m < 4; ++m) {
                float* rowp = O + (size_t)(row0 + ai * HALF + m * 16) * ldc + col0;
#pragma unroll
                for (int bj = 0; bj < 2; ++bj) { *(f32x4*)(rowp + bj * HALF) = acc[ai][bj][m][0]; *(f32x4*)(rowp + bj * HALF + 4) = acc[ai][bj][m][1]; }
            }
    }
};
struct EpiB16 {
    static constexpr bool PERM = true, AFTER_DRAIN = false;
    bf16_t* O; int ldc;
    __device__ __forceinline__ void operator()(const f32x4 (&acc)[2][2][4][2], const Unit& u, int wr, int wc, int fr, int fq) const {
        const int row0 = u.pm * BM + wr * 64 + fr, col0 = u.pn * BM + wc * 32 + 8 * fq;
#pragma unroll
        for (int ai = 0; ai < 2; ++ai)
#pragma unroll
            for (int m = 0; m < 4; ++m) {
                bf16_t* rowp = O + (size_t)(row0 + ai * HALF + m * 16) * ldc + col0;
#pragma unroll
                for (int bj = 0; bj < 2; ++bj) { const f32x4 v0 = acc[ai][bj][m][0], v1 = acc[ai][bj][m][1];
                    u32x4 w; w.x = cvt_pk_bf16(v0[0], v0[1]); w.y = cvt_pk_bf16(v0[2], v0[3]); w.z = cvt_pk_bf16(v1[0], v1[1]); w.w = cvt_pk_bf16(v1[2], v1[3]);
                    *(u32x4*)(rowp + bj * HALF) = w; }
            }
    }
};

struct EpiMulti {
    static constexpr bool PERM = true, AFTER_DRAIN = false;
    int mode; void* O; int ldc; void* O2;
    __device__ __forceinline__ void operator()(const f32x4 (&acc)[2][2][4][2], const Unit& u, int wr, int wc, int fr, int fq) const {
        if (u.sp && mode == 2) { Unit v = u; v.pm = u.ko >> 8; EpiB16 e{(bf16_t*)O2, ldc}; e(acc, v, wr, wc, fr, fq); }
        else if (mode == 0) { EpiSwiGLU e{(bf16_t*)O, ldc}; e(acc, u, wr, wc, fr, fq); }
        else if (mode == 4) { Unit v = u; v.pm = u.ko >> 8; EpiB16 e{(bf16_t*)O, ldc}; e(acc, v, wr, wc, fr, fq); }
        else { EpiB16 e{(bf16_t*)O, ldc}; e(acc, u, wr, wc, fr, fq); }
    }
};
template <class Epi, class Sched, bool ALIGN_EPI = false, bool SP2 = false>
__device__ __forceinline__ void gemm_phase(PG8_LAS unsigned char* lds, const Gemm g, const Sched& S, const Epi& E) {
    const int tid = threadIdx.x, wid = __builtin_amdgcn_readfirstlane(tid >> 6), lane = tid & 63, wr = wid >> 2, wc = wid & 3, fr = lane & 15, fq = lane >> 4;
    const int K = g.ld; int nt = g.K / BK;
    unsigned voffA[2], voffB[2];
#pragma unroll
    for (int i = 0; i < 2; ++i) { int R, C; stage_rc(tid * 16 + i * 8192, R, C); const int Rb = Epi::PERM ? ((R & ~31) + perm32(R & 31)) : R;
        voffA[i] = (unsigned)(R * K + C) * 2u; voffB[i] = (unsigned)(Rb * K + C) * 2u; }
    const size_t kstep = (size_t)(BK * 2);
    const size_t hstep = (size_t)HALF * K * 2;
    const size_t tstep = 2 * hstep;
    const unsigned ldsw = (unsigned)wid * 1024u;
    const int aoff = lds_byte(wr * 64 + fr, fq * 8), boff = lds_byte(wc * 32 + fr, fq * 8);
#define PG8_SA(b, h) (((b) * 2 + (h)) * HTB)
#define PG8_SB(b, h) ((4 + (b) * 2 + (h)) * HTB)
#define PG8_STAGE(bufoff, gbase, voff) do { _Pragma("unroll") for (int _i = 0; _i < 2; ++_i) \
        __builtin_amdgcn_global_load_lds((const unsigned*)((const char*)(gbase) + (voff)[_i]), (PG8_LAS unsigned*)(lds + (bufoff) + ldsw + _i * 8192), 16, 0, 0); } while (0)
#define PG8_LDA(dst, b, h) do { _Pragma("unroll") for (int m = 0; m < 4; ++m) _Pragma("unroll") for (int k = 0; k < 2; ++k) dst[m][k] = *(const PG8_LAS bf16x8*)(lds + PG8_SA(b, h) + aoff + m * 2048 + k * 1024); } while (0)
#define PG8_LDB(dst, b, h) do { _Pragma("unroll") for (int n = 0; n < 2; ++n) _Pragma("unroll") for (int k = 0; k < 2; ++k) dst[n][k] = *(const PG8_LAS bf16x8*)(lds + PG8_SB(b, h) + boff + n * 2048 + k * 1024); } while (0)
#define PG8_MMA(ai, bj, At, Bt) do { __builtin_amdgcn_s_setprio(1); _Pragma("unroll") for (int m = 0; m < 4; ++m) _Pragma("unroll") for (int n = 0; n < 2; ++n) _Pragma("unroll") for (int k = 0; k < 2; ++k) \
        acc[ai][bj][m][n] = __builtin_amdgcn_mfma_f32_16x16x32_bf16(Bt[n][k], At[m][k], acc[ai][bj][m][n], 0, 0, 0); __builtin_amdgcn_s_setprio(0); } while (0)
#define PG8_WAIT_V(n) asm volatile("s_waitcnt vmcnt(" #n ")" ::: "memory")
#define PG8_WAIT_L(n) asm volatile("s_waitcnt lgkmcnt(" #n ")" ::: "memory")
#define PG8_BAR __builtin_amdgcn_s_barrier()
#define PG8_SCHED __builtin_amdgcn_sched_barrier(0)
    Unit cur, nxt; int ui = 0;
    if (!S.next(0, cur)) return;
    if (cur.nt > 0) nt = cur.nt;
    f32x4 acc[2][2][4][2];
#pragma unroll
    for (int a = 0; a < 2; ++a)
#pragma unroll
        for (int b = 0; b < 2; ++b)
#pragma unroll
            for (int m = 0; m < 4; ++m)
#pragma unroll
                for (int n = 0; n < 2; ++n) acc[a][b][m][n] = (f32x4){0.f, 0.f, 0.f, 0.f};
    bf16x8 At[4][2], B0[2][2], B1[2][2];
    const char* cA = (const char*)g.A + (size_t)cur.pm * tstep + (size_t)cur.ko * 2; const char* cB = (const char*)g.Bt + (size_t)cur.pn * tstep + (size_t)cur.ko * 2;
    S.a_ready(cur);
    if constexpr (SP2) {
        PG8_STAGE(PG8_SB(0, 0), cB, voffB); PG8_STAGE(PG8_SB(0, 1), cB + hstep, voffB); PG8_STAGE(PG8_SA(0, 0), cA, voffA); PG8_STAGE(PG8_SA(0, 1), cA + hstep, voffA);
        if (wr == 1) PG8_BAR;
        PG8_WAIT_V(2); PG8_BAR;
        PG8_STAGE(PG8_SB(1, 0), cB + kstep, voffB); PG8_STAGE(PG8_SA(1, 0), cA + kstep, voffA); PG8_STAGE(PG8_SB(1, 1), cB + hstep + kstep, voffB);
        PG8_WAIT_V(6); PG8_BAR;
    } else {
        PG8_STAGE(PG8_SB(0, 0), cB, voffB); PG8_STAGE(PG8_SA(0, 0), cA, voffA); PG8_STAGE(PG8_SB(0, 1), cB + hstep, voffB); PG8_STAGE(PG8_SA(0, 1), cA + hstep, voffA);
        if (wr == 1) PG8_BAR;
        PG8_WAIT_V(4); PG8_BAR;
        PG8_STAGE(PG8_SB(1, 0), cB + kstep, voffB); PG8_STAGE(PG8_SA(1, 0), cA + kstep, voffA); PG8_STAGE(PG8_SB(1, 1), cB + hstep + kstep, voffB);
        PG8_WAIT_V(6); PG8_BAR;
    }
    for (;;) {
        const bool has_next = S.next(ui + 1, nxt);
        const char* nA = has_next ? (const char*)g.A + (size_t)nxt.pm * tstep + (size_t)nxt.ko * 2 : cA; const char* nB = has_next ? (const char*)g.Bt + (size_t)nxt.pn * tstep + (size_t)nxt.ko * 2 : cB;
        for (int t = 0; t < nt; t += 2) {
            const bool last = (t == nt - 2);
            const char* a1 = cA + (size_t)(t + 1) * kstep;
            const char* a2 = last ? nA : cA + (size_t)(t + 2) * kstep; const char* b2 = last ? nB : cB + (size_t)(t + 2) * kstep;
            const char* a3 = a2 + kstep; const char* b3 = b2 + kstep;
            if (last && has_next) S.a_ready(nxt);
            if constexpr (SP2) {
            PG8_LDB(B0, 0, 0); PG8_LDB(B1, 0, 1); PG8_SCHED; PG8_LDA(At, 0, 0); PG8_STAGE(PG8_SA(1, 1), a1 + hstep, voffA);
            PG8_WAIT_V(8); PG8_WAIT_L(0); PG8_BAR; PG8_MMA(0, 0, At, B0); PG8_MMA(0, 1, At, B1); PG8_BAR; PG8_SCHED;
            PG8_LDA(At, 0, 1); PG8_STAGE(PG8_SB(0, 0), b2, voffB); PG8_STAGE(PG8_SB(0, 1), b2 + hstep, voffB); PG8_STAGE(PG8_SA(0, 0), a2, voffA);
            PG8_WAIT_V(8); PG8_WAIT_L(0); PG8_BAR; PG8_MMA(1, 0, At, B0); PG8_MMA(1, 1, At, B1); PG8_BAR; PG8_SCHED;
            PG8_LDB(B0, 1, 0); PG8_LDB(B1, 1, 1); PG8_SCHED; PG8_LDA(At, 1, 0); PG8_STAGE(PG8_SA(0, 1), a2 + hstep, voffA);
            PG8_WAIT_V(8); PG8_WAIT_L(0); PG8_BAR; PG8_MMA(0, 0, At, B0); PG8_MMA(0, 1, At, B1); PG8_BAR; PG8_SCHED;
            PG8_LDA(At, 1, 1); PG8_STAGE(PG8_SB(1, 0), b3, voffB); PG8_STAGE(PG8_SB(1, 1), b3 + hstep, voffB); PG8_STAGE(PG8_SA(1, 0), a3, voffA);
            PG8_WAIT_V(8); PG8_WAIT_L(0); PG8_BAR; PG8_MMA(1, 0, At, B0); PG8_MMA(1, 1, At, B1); PG8_BAR; PG8_SCHED;
            } else {
            PG8_LDB(B0, 0, 0); PG8_SCHED; PG8_LDA(At, 0, 0); PG8_STAGE(PG8_SA(1, 1), a1 + hstep, voffA);
            PG8_WAIT_L(8); PG8_BAR; PG8_WAIT_L(0); PG8_MMA(0, 0, At, B0); PG8_BAR; PG8_SCHED;
            PG8_LDB(B1, 0, 1); PG8_STAGE(PG8_SB(0, 0), b2, voffB);
            PG8_BAR; PG8_WAIT_L(0); PG8_MMA(0, 1, At, B1); PG8_BAR;
            PG8_LDA(At, 0, 1); PG8_STAGE(PG8_SA(0, 0), a2, voffA);
            PG8_BAR; PG8_WAIT_L(0); PG8_MMA(1, 0, At, B0); PG8_BAR; PG8_SCHED;
            PG8_STAGE(PG8_SB(0, 1), b2 + hstep, voffB);
            PG8_WAIT_V(6); PG8_BAR; PG8_MMA(1, 1, At, B1); PG8_BAR;
            PG8_LDB(B0, 1, 0); PG8_SCHED; PG8_LDA(At, 1, 0); PG8_STAGE(PG8_SA(0, 1), a2 + hstep, voffA);
            PG8_WAIT_L(8); PG8_BAR; PG8_WAIT_L(0); PG8_MMA(0, 0, At, B0); PG8_BAR; PG8_SCHED;
            PG8_LDB(B1, 1, 1); PG8_STAGE(PG8_SB(1, 0), b3, voffB);
            PG8_BAR; PG8_WAIT_L(0); PG8_MMA(0, 1, At, B1); PG8_BAR;
            PG8_LDA(At, 1, 1); PG8_STAGE(PG8_SA(1, 0), a3, voffA);
            PG8_BAR; PG8_WAIT_L(0); PG8_MMA(1, 0, At, B0); PG8_BAR; PG8_SCHED;
            PG8_STAGE(PG8_SB(1, 1), b3 + hstep, voffB);
            PG8_WAIT_V(6); PG8_BAR; PG8_MMA(1, 1, At, B1); PG8_BAR;
            }
        }
        if constexpr (ALIGN_EPI) { if (wr == 0) PG8_BAR; }
        if constexpr (!Epi::AFTER_DRAIN) { E(acc, cur, wr, wc, fr, fq); S.done(cur); }
        if (!has_next) break;
#pragma unroll
        for (int a = 0; a < 2; ++a)
#pragma unroll
            for (int b = 0; b < 2; ++b)
#pragma unroll
                for (int m = 0; m < 4; ++m)
#pragma unroll
                    for (int n = 0; n < 2; ++n) acc[a][b][m][n] = (f32x4){0.f, 0.f, 0.f, 0.f};
        cur = nxt; cA = nA; cB = nB; ++ui; if (cur.nt > 0) nt = cur.nt;
        if constexpr (ALIGN_EPI) { if (wr == 1) PG8_BAR; }
    }
    PG8_WAIT_V(0);
    if constexpr (!ALIGN_EPI) { if (wr == 0) PG8_BAR; }
    PG8_BAR;
    if constexpr (Epi::AFTER_DRAIN) { E.fused(acc, cur, wr, wc, fr, fq, lds, wid, lane); S.done(cur); }
#undef PG8_SA
#undef PG8_SB
#undef PG8_STAGE
#undef PG8_LDA
#undef PG8_LDB
#undef PG8_MMA
#undef PG8_WAIT_V
#undef PG8_WAIT_L
#undef PG8_BAR
#undef PG8_SCHED
}
}

#ifndef MK_NO_PRO
#define MK_NO_PRO 0
#endif
#ifndef MK_NO_MIX1
#define MK_NO_MIX1 0
#endif
#ifndef MK_NO_MIX2
#define MK_NO_MIX2 0
#endif
#ifndef MK_NO_G1
#define MK_NO_G1 0
#endif
#ifndef MK_NO_G2
#define MK_NO_G2 0
#endif
#ifndef MK_NO_G3
#define MK_NO_G3 0
#endif
#ifndef MK_CHECK
#define MK_CHECK 0
#endif
#ifndef MK_PROBE
#define MK_PROBE 0
#endif
#ifndef MK_DEFER_WIN
#define MK_DEFER_WIN 1
#endif
#ifndef MK_STREAM_TAIL
#define MK_STREAM_TAIL 1
#endif
#ifndef MK_ONE_LAUNCH
#define MK_ONE_LAUNCH 1
#endif
namespace mk {
#define LAS __attribute__((address_space(3)))
typedef unsigned short bf16_t;
typedef float f32x4 __attribute__((ext_vector_type(4)));
typedef unsigned u32x4 __attribute__((ext_vector_type(4)));
typedef unsigned u32x2 __attribute__((ext_vector_type(2)));
constexpr int NWAVES = 8, NTHR = 512;
constexpr int D = 1024, TP = 16384, NSB = 8, TSS = 16, MV = 16512, MP = 16640, DFF = 2816, DIN = 2304, NL = 4;
constexpr int DA = 256, DB = 512, DC = 256;
constexpr int COL_AB = 0, COL_AC = 256, COL_AX = 512, COL_BX = 768, COL_BG = 1280, COL_CV = 1792, COL_CG = 2048;
constexpr float EPS = 1e-6f;
constexpr int LDS_BYTES = 147456;
constexpr size_t MiB = 1u << 20;
constexpr size_t WS_W13 = 1 * MiB, WS_W2 = 89 * MiB, WS_WIN = 133 * MiB, WS_WOUT = 151 * MiB, WS_MOD = 159 * MiB, WS_AGG = 161 * MiB,
                 WS_X = 163 * MiB, WS_F = 228 * MiB, WS_H = 293 * MiB, WS_Y = 326 * MiB, WS_HL = 359 * MiB, WS_AC = 392 * MiB, WS_GU = 425 * MiB, WS_FPART = 515 * MiB, WS_END = 521 * MiB;
constexpr size_t W13_BYTES = (size_t)2 * DFF * D * 2, W2_BYTES = (size_t)D * DFF * 2, WIN_BYTES = (size_t)DIN * D * 2, WOUT_BYTES = (size_t)D * D * 2;
constexpr size_t O_Y = 0, O_CAP = 16908288, O_CBP = 16910336, O_HP = 16916480, O_CCP = 16918528, O_CAS = 16949248, O_CBS = 16965632, O_HS = 17014784, O_CCS = 17031168, O_END = 17276928;
constexpr int NPH = 2 + 11 * NL;
constexpr int NSTEP = MK_PROBE == 4 ? NPH + 1 : (MK_PROBE == 2 || MK_PROBE == 3) ? 2 + 12 * NL : (MK_PROBE == 5 || MK_PROBE == 6) ? 2 + 14 * NL : NPH;
constexpr int NCHUNK = 256 + NSB;

struct Args { const float* in[30]; float* out; unsigned char* ws; int ph_lo, ph_hi; };
typedef const __attribute__((address_space(4))) Args* CArgs;
enum { I_XP = 0, I_XS, I_SA, I_SB, I_SH, I_SC, I_CP, I_CS, I_WADA, I_BADA, I_NPRE, I_NPOST, I_W1, I_W3, I_W2, I_WIN, I_WOUT, I_WCA, I_WCB, I_BCB,
       I_WGR, I_BGR, I_WGI, I_BGI, I_LAM, I_WCC, I_BCC, I_LNG, I_LNB, I_GRP };

__device__ __forceinline__ float wave_sum_l(float v, int lane) {
#pragma unroll
    for (int o = 1; o < 64; o <<= 1) v += __builtin_bit_cast(float, __builtin_amdgcn_ds_bpermute((lane ^ o) << 2, __builtin_bit_cast(int, v)));
    return v;
}
#define wave_sum(v) wave_sum_l((v), lane)
#define LDS_BARRIER() do { asm volatile("s_waitcnt lgkmcnt(0)" ::: "memory"); __builtin_amdgcn_s_barrier(); asm volatile("" ::: "memory"); } while (0)
__device__ __forceinline__ void wave_sum4_l(float& a, float& b, float& c, float& d, int lane) {
#pragma unroll
    for (int o = 1; o < 64; o <<= 1) { const int idx = (lane ^ o) << 2;
        const float a2 = __builtin_bit_cast(float, __builtin_amdgcn_ds_bpermute(idx, __builtin_bit_cast(int, a))), b2 = __builtin_bit_cast(float, __builtin_amdgcn_ds_bpermute(idx, __builtin_bit_cast(int, b)));
        const float c2 = __builtin_bit_cast(float, __builtin_amdgcn_ds_bpermute(idx, __builtin_bit_cast(int, c))), d2 = __builtin_bit_cast(float, __builtin_amdgcn_ds_bpermute(idx, __builtin_bit_cast(int, d)));
        a += a2; b += b2; c += c2; d += d2; }
}
__device__ __forceinline__ unsigned f2bf(float f) { unsigned u = __builtin_bit_cast(unsigned, f); return (u + 0x7fffu + ((u >> 16) & 1u)) >> 16; }
__device__ __forceinline__ unsigned pk2(float lo, float hi) { unsigned r; asm("v_cvt_pk_bf16_f32 %0, %1, %2" : "=v"(r) : "v"(lo), "v"(hi)); return r; }
__device__ __forceinline__ float bflo(unsigned u) { return __builtin_bit_cast(float, u << 16); }
__device__ __forceinline__ float bfhi(unsigned u) { return __builtin_bit_cast(float, u & 0xffff0000u); }
__device__ __forceinline__ f32x4 ld_bf4(const bf16_t* p) { const u32x2 v = *(const u32x2*)p; return (f32x4){bflo(v.x), bfhi(v.x), bflo(v.y), bfhi(v.y)}; }
__device__ __forceinline__ float bf1(const bf16_t* p) { return __builtin_bit_cast(float, (unsigned)(*p) << 16); }
__device__ __forceinline__ float sigm(float x) { return __builtin_amdgcn_rcpf(1.0f + __builtin_amdgcn_exp2f(-1.44269504089f * x)); }
__device__ __forceinline__ float gelu_tanh(float x) { return x * sigm(1.5957691216f * (x + 0.044715f * x * x * x)); }
__device__ __forceinline__ float hsum4(f32x4 v) { return (v[0] + v[1]) + (v[2] + v[3]); }
__device__ __forceinline__ float hsq4(f32x4 v) { return (v[0] * v[0] + v[1] * v[1]) + (v[2] * v[2] + v[3] * v[3]); }

__device__ __forceinline__ void transpose_item(const float* W, int K, int N, bf16_t* WT, LAS float* scr, int kb, int nb, int dst_row0, int lane) {
    const int k0 = 64 * kb, n0 = 32 * nb;
#pragma unroll 8
    for (int i = 0; i < 32; ++i) { const int kk = 2 * i + (lane >> 5); scr[kk * 33 + (lane & 31)] = W[(size_t)(k0 + kk) * N + n0 + (lane & 31)]; }
    asm volatile("s_waitcnt lgkmcnt(0)" ::: "memory");
    const int c = lane & 7;
#pragma unroll
    for (int j = 0; j < 4; ++j) { const int n = (lane >> 3) + 8 * j; const LAS float* s = scr + (8 * c) * 33 + n;
        u32x4 o; o.x = pk2(s[0 * 33], s[1 * 33]); o.y = pk2(s[2 * 33], s[3 * 33]); o.z = pk2(s[4 * 33], s[5 * 33]); o.w = pk2(s[6 * 33], s[7 * 33]);
        *(u32x4*)(WT + (size_t)(dst_row0 + n) * K + k0 + 8 * c) = o; }
    asm volatile("s_waitcnt lgkmcnt(0)" ::: "memory");
}

__device__ __forceinline__ void phase_prologue(CArgs a, LAS unsigned char* lds, int tid, int lane, int wave) {
    unsigned char* ws = a->ws;
    {
        LAS float* sc = (LAS float*)lds;
        LAS float* red = sc + 9 * 1024;
        for (int e = tid; e < 9 * 1024; e += NTHR) { const int b = e >> 10, k = e & 1023; const float c = b == 0 ? a->in[I_CP][k] : a->in[I_CS][(b - 1) * 1024 + k]; sc[e] = c * sigm(c); }
        __syncthreads();
        float* mod = (float*)(ws + WS_MOD);
        const int kk = tid >> 5, cl = tid & 31;
        for (int u = blockIdx.x; u < NL * 72; u += gridDim.x) {
            const int l = u / 72, n0 = 128 * (u % 72);
            f32x4 acc[9];
#pragma unroll
            for (int b = 0; b < 9; ++b) acc[b] = (f32x4){0.f, 0.f, 0.f, 0.f};
            const float* wp = a->in[I_WADA] + (size_t)l * 1024 * 9216 + n0 + 4 * cl;
#pragma unroll 4
            for (int k = kk; k < 1024; k += 16) {
                const f32x4 w = *(const f32x4*)(wp + (size_t)k * 9216);
#pragma unroll
                for (int b = 0; b < 9; ++b) acc[b] += sc[b * 1024 + k] * w;
            }
#pragma unroll
            for (int b = 0; b < 9; ++b)
#pragma unroll
                for (int e = 0; e < 4; ++e) { const float av = acc[b][e]; acc[b][e] = av + __builtin_bit_cast(float, __builtin_amdgcn_ds_bpermute((lane ^ 32) << 2, __builtin_bit_cast(int, av))); }
            if (lane < 32) {
#pragma unroll
                for (int b = 0; b < 9; ++b) *(LAS f32x4*)(red + (wave * 9 + b) * 128 + 4 * cl) = acc[b];
            }
            __syncthreads();
            for (int o = tid; o < 9 * 128; o += NTHR) {
                const int b = o >> 7, c = o & 127; float s = 0.f;
#pragma unroll
                for (int w = 0; w < 8; ++w) s += red[(w * 9 + b) * 128 + c];
                mod[((size_t)l * 9 + b) * 9216 + n0 + c] = s + a->in[I_BADA][l * 9216 + n0 + c];
            }
            __syncthreads();
        }
    }
    __syncthreads();
    {
        LAS float* scr = (LAS float*)(lds + wave * 8448);
        const int gw = blockIdx.x * NWAVES + wave, NGW = gridDim.x * NWAVES;
        constexpr int I13 = 16 * 88, I2 = 44 * 32, IIN = 16 * 72, IOUT = 16 * 32;
        constexpr int PER_L = 4 * I13 + 2 * I2 + IIN + IOUT;
        for (int it = gw; it < NL * PER_L; it += NGW) {
            const int l = it / PER_L; int r = it % PER_L;
            if (r < 4 * I13) {
                const int which = r / (2 * I13); r %= 2 * I13; const int s = r / I13, q = r % I13, kb = q / 88, nb = q % 88;
                const float* W = a->in[which ? I_W3 : I_W1] + (size_t)(l * 2 + s) * D * DFF;
                bf16_t* WT = (bf16_t*)(ws + WS_W13 + (size_t)(l * 2 + s) * W13_BYTES);
                const int n0 = 32 * nb, dst = (n0 >> 7) * 256 + (n0 & 127) + (which ? 128 : 0);
                transpose_item(W, D, DFF, WT, scr, kb, nb, dst, lane);
                continue;
            }
            r -= 4 * I13;
            if (r < 2 * I2) {
                const int s = r / I2, q = r % I2, kb = q / 32, nb = q % 32;
                transpose_item(a->in[I_W2] + (size_t)(l * 2 + s) * DFF * D, DFF, D, (bf16_t*)(ws + WS_W2 + (size_t)(l * 2 + s) * W2_BYTES), scr, kb, nb, 32 * nb, lane);
                continue;
            }
            r -= 2 * I2;
            if (r < IIN) { const int kb = r / 72, nb = r % 72;
                transpose_item(a->in[I_WIN] + (size_t)l * D * DIN, D, DIN, (bf16_t*)(ws + WS_WIN + (size_t)l * WIN_BYTES), scr, kb, nb, 32 * nb, lane); continue; }
            r -= IIN;
            { const int kb = r / 32, nb = r % 32;
                transpose_item(a->in[I_WOUT] + (size_t)l * D * D, D, D, (bf16_t*)(ws + WS_WOUT + (size_t)l * WOUT_BYTES), scr, kb, nb, 32 * nb, lane); }
        }
    }
}

__device__ __forceinline__ void phase_rows(CArgs a, int lane, int wave, int mode, bool final_, float coef, int nsplit,
                                           const float* modc, int gidx, const float* gpost, const float* modn, int scidx, int shidx, const float* gpre) {
    unsigned char* ws = a->ws;
    bf16_t* X = (bf16_t*)(ws + WS_X); const bf16_t* Fb = (const bf16_t*)(ws + WS_F); bf16_t* H = (bf16_t*)(ws + WS_H);
    const int gw = blockIdx.x * NWAVES + wave, NGW = gridDim.x * NWAVES;
    {
        f32x4 gg[4], gs[4], tt[4];
#pragma unroll
        for (int j = 0; j < 4; ++j) { const int c = 4 * lane + 256 * j;
            gg[j] = mode ? coef * *(const f32x4*)(modc + (size_t)gidx * D + c) * *(const f32x4*)(gpost + c) : (f32x4){0.f, 0.f, 0.f, 0.f};
            gs[j] = *(const f32x4*)(gpre + c) * (1.0f + *(const f32x4*)(modn + (size_t)scidx * D + c));
            tt[j] = *(const f32x4*)(modn + (size_t)shidx * D + c); }
        const float* xin = a->in[I_XP];
        constexpr int LA = 3;
        u32x2 xq[LA + 1][4], fq[LA + 1][4]; f32x4 xf[LA + 1][4];
#define ROWS_LOAD(S_, R_) do { if ((R_) < TP) { _Pragma("unroll") for (int j = 0; j < 4; ++j) { const size_t o_ = (size_t)(R_) * D + 4 * lane + 256 * j; \
            if (mode) { xq[S_][j] = *(const u32x2*)(X + o_); fq[S_][j] = *(const u32x2*)(Fb + o_); } else xf[S_][j] = *(const f32x4*)(xin + o_); } } } while (0)
        int r = gw;
        ROWS_LOAD(0, r); ROWS_LOAD(1, r + NGW); ROWS_LOAD(2, r + 2 * NGW);
        while (r < TP) {
            ROWS_LOAD(3, r + 3 * NGW);
            f32x4 x[4];
            if (mode) {
                f32x4 f[4]; float ss = 0.f;
#pragma unroll
                for (int j = 0; j < 4; ++j) { f[j] = (f32x4){bflo(fq[0][j].x), bfhi(fq[0][j].x), bflo(fq[0][j].y), bfhi(fq[0][j].y)}; ss += hsq4(f[j]); }
                const float rstd = __builtin_amdgcn_rsqf(wave_sum(ss) * (1.0f / D) + EPS);
#pragma unroll
                for (int j = 0; j < 4; ++j) x[j] = (f32x4){bflo(xq[0][j].x), bfhi(xq[0][j].x), bflo(xq[0][j].y), bfhi(xq[0][j].y)} + gg[j] * (f[j] * rstd);
            } else {
#pragma unroll
                for (int j = 0; j < 4; ++j) x[j] = xf[0][j];
            }
            if (final_) {
#pragma unroll
                for (int j = 0; j < 4; ++j) *(f32x4*)(a->out + (size_t)r * D + 4 * lane + 256 * j) = x[j];
            } else {
                float ss = 0.f;
#pragma unroll
                for (int j = 0; j < 4; ++j) { u32x2 xo; xo.x = pk2(x[j][0], x[j][1]); xo.y = pk2(x[j][2], x[j][3]); *(u32x2*)(X + (size_t)r * D + 4 * lane + 256 * j) = xo;
                    x[j] = (f32x4){bflo(xo.x), bfhi(xo.x), bflo(xo.y), bfhi(xo.y)}; ss += hsq4(x[j]); }
                const float rstd = __builtin_amdgcn_rsqf(wave_sum(ss) * (1.0f / D) + EPS);
#pragma unroll
                for (int j = 0; j < 4; ++j) { const f32x4 h = (x[j] * rstd) * gs[j] + tt[j];
                    u32x2 o; o.x = pk2(h[0], h[1]); o.y = pk2(h[2], h[3]);
                    *(u32x2*)(H + (size_t)r * D + 4 * lane + 256 * j) = o; }
            }
#pragma unroll
            for (int s = 0; s < LA; ++s)
#pragma unroll
                for (int j = 0; j < 4; ++j) { xq[s][j] = xq[s + 1][j]; fq[s][j] = fq[s + 1][j]; xf[s][j] = xf[s + 1][j]; }
            r += NGW;
        }
#undef ROWS_LOAD
    }
    for (int r = TP + gw; r < MV; r += NGW) {
        const int bidx = 1 + ((r - TP) >> 4);
        f32x4 x[4];
        if (mode == 0) {
            const float* src = a->in[I_XS] + (size_t)(r - TP) * D;
#pragma unroll
            for (int j = 0; j < 4; ++j) x[j] = *(const f32x4*)(src + 4 * lane + 256 * j);
        } else {
            f32x4 f[4]; float ss = 0.f;
#pragma unroll
            for (int j = 0; j < 4; ++j) {
                u32x2 pr[11];
#pragma unroll
                for (int s = 0; s < 11; ++s) pr[s] = s < nsplit ? *(const u32x2*)((const bf16_t*)(ws + WS_FPART) + ((size_t)s * 256 + (r - TP)) * D + 4 * lane + 256 * j) : (u32x2){0u, 0u};
                f[j] = (f32x4){0.f, 0.f, 0.f, 0.f};
#pragma unroll
                for (int s = 0; s < 11; ++s) f[j] += (f32x4){bflo(pr[s].x), bfhi(pr[s].x), bflo(pr[s].y), bfhi(pr[s].y)};
                ss += hsq4(f[j]); }
#pragma unroll
            for (int j = 0; j < 4; ++j) x[j] = ld_bf4(X + (size_t)r * D + 4 * lane + 256 * j);
            const float rstd = coef * __builtin_amdgcn_rsqf(wave_sum(ss) * (1.0f / D) + EPS);
            const float* gate = modc + ((size_t)bidx * 9 + gidx) * D;
#pragma unroll
            for (int j = 0; j < 4; ++j) { const f32x4 g = *(const f32x4*)(gate + 4 * lane + 256 * j), gp = *(const f32x4*)(gpost + 4 * lane + 256 * j);
                x[j] += g * (f[j] * rstd * gp); }
        }
        if (final_) {
#pragma unroll
            for (int j = 0; j < 4; ++j) *(f32x4*)(a->out + (size_t)r * D + 4 * lane + 256 * j) = x[j];
        } else {
            float ss = 0.f;
#pragma unroll
            for (int j = 0; j < 4; ++j) { u32x2 xo; xo.x = pk2(x[j][0], x[j][1]); xo.y = pk2(x[j][2], x[j][3]); *(u32x2*)(X + (size_t)r * D + 4 * lane + 256 * j) = xo;
                x[j] = (f32x4){bflo(xo.x), bfhi(xo.x), bflo(xo.y), bfhi(xo.y)}; ss += hsq4(x[j]); }
            const float rstd = __builtin_amdgcn_rsqf(wave_sum(ss) * (1.0f / D) + EPS);
            const float* sc = modn + ((size_t)bidx * 9 + scidx) * D; const float* sh = modn + ((size_t)bidx * 9 + shidx) * D;
#pragma unroll
            for (int j = 0; j < 4; ++j) { const int c = 4 * lane + 256 * j;
                const f32x4 g = *(const f32x4*)(gpre + c), s = *(const f32x4*)(sc + c), t = *(const f32x4*)(sh + c);
                const f32x4 h = (x[j] * rstd * g) * (1.0f + s) + t;
                u32x2 o; o.x = pk2(h[0], h[1]); o.y = pk2(h[2], h[3]);
                *(u32x2*)(H + (size_t)r * D + c) = o; }
        }
    }
}

typedef short bf16x8v __attribute__((ext_vector_type(8)));
typedef float f32x16 __attribute__((ext_vector_type(16)));
__device__ __forceinline__ void phase_mix1(CArgs a, LAS unsigned char* lds, int l, int tid, int lane, int wave, bool defer_win) {
    unsigned char* ws = a->ws;
    const bf16_t* U = (const bf16_t*)(ws + WS_GU);
    float* AGG = (float*)(ws + WS_AGG);
    LAS bf16_t* XB = (LAS bf16_t*)lds;
    LAS bf16_t* WT = XB + 64 * 72;
    LAS float* PRE = (LAS float*)(WT + 2 * 64 * 72);
    LAS float* comb = PRE + 2 * 64 * 64;
    const int j = lane, tg = wave;
    const int mg = wave & 1, mtb = (wave >> 1) & 1, mjb = wave >> 2, mr = lane & 31, mh = lane >> 5;
    float wcb[4];
    float br = 0.f, bi = 0.f, lsig = 0.f, bcb = 0.f;
    int cur_head = -1;
    unsigned* HLAC = (unsigned*)(ws + WS_HL);
    float bx[11];
    unsigned short rawu[11]; float raws[11];
#define MIX1_ISSUE(W_) do { const int head_ = (W_) & 7, chunk_ = (W_) >> 3, chg_ = 64 * head_ + j; const bool smp_ = chunk_ >= 256; \
        const int sb_ = smp_ ? chunk_ - 256 : 0, row0_ = smp_ ? TP + TSS * sb_ : 64 * chunk_; \
        const float* sbp_ = a->in[I_SB] + (size_t)(l * NSB + sb_) * 3 * DB + chg_; \
        _Pragma("unroll") for (int q = 0; q < 11; ++q) { const int t_ = tg * 8 - 3 + q; int ru_ = row0_ + t_; \
            ru_ = ru_ < 0 ? 0 : (ru_ > MV - 1 ? MV - 1 : ru_); int si_ = 3 + t_; si_ = si_ < 0 ? 0 : (si_ > 2 ? 2 : si_); \
            rawu[q] = U[(size_t)ru_ * DIN + COL_BX + chg_]; raws[q] = sbp_[(size_t)si_ * DB]; } \
        __builtin_amdgcn_sched_barrier(0); } while (0)
#define MIX1_CONSUME(W_) do { const int chunk_ = (W_) >> 3; const bool smp_ = chunk_ >= 256; \
        const int row0_ = smp_ ? TP + TSS * (chunk_ - 256) : 64 * chunk_, len_ = smp_ ? TSS : 64; \
        _Pragma("unroll") for (int q = 0; q < 11; ++q) { const int t_ = tg * 8 - 3 + q; const int ru_ = row0_ + t_; \
            const bool uok_ = (t_ < len_) && (ru_ >= 0) && (t_ >= 0 || !smp_), sok_ = smp_ && t_ < 0; \
            bx[q] = __builtin_bit_cast(float, (unsigned)rawu[q] << 16) * (uok_ ? 1.0f : 0.0f) + raws[q] * (sok_ ? 1.0f : 0.0f); } } while (0)
    int w0 = (int)blockIdx.x, wstep = (int)gridDim.x, wend = 8 * NCHUNK;
    if (defer_win) { const int hd = (int)blockIdx.x & 7, rk = (int)blockIdx.x >> 3;
        if (rk < 22) { w0 = rk * 8 + hd; wstep = 22 * 8; wend = 214 * 8; } else { w0 = (214 + rk - 22) * 8 + hd; wstep = 10 * 8; wend = 8 * NCHUNK; } }
    if (w0 < wend) MIX1_ISSUE(w0);
    for (int w = w0; w < wend; w += wstep) {
        const int head = w & 7, chunk = w >> 3, chg = 64 * head + j;
        if (head != cur_head) {
            cur_head = head;
            LDS_BARRIER();
            const float* pr = a->in[I_WGR] + (size_t)(l * 8 + head) * 4096; const float* pi = a->in[I_WGI] + (size_t)(l * 8 + head) * 4096;
            for (int e = tid; e < 4096; e += NTHR) { const int k = e >> 6, jj = e & 63; WT[jj * 72 + k] = (bf16_t)f2bf(pr[e]); WT[64 * 72 + jj * 72 + k] = (bf16_t)f2bf(pi[e]); }
            br = a->in[I_BGR][l * DB + chg]; bi = a->in[I_BGI][l * DB + chg];
            const float lam = a->in[I_LAM][l * DB + chg]; lsig = -log1pf(expf(-lam));
#pragma unroll
            for (int k = 0; k < 4; ++k) wcb[k] = a->in[I_WCB][(l * 4 + k) * DB + chg];
            bcb = a->in[I_BCB][l * DB + chg];
        }
        int row0, len;
        if (chunk < 256) { row0 = 64 * chunk; len = 64; } else { row0 = TP + TSS * (chunk - 256); len = TSS; }
        MIX1_CONSUME(w);
        float xb[8];
#pragma unroll
        for (int i = 0; i < 8; ++i) { xb[i] = bcb + wcb[0] * bx[i] + wcb[1] * bx[i + 1] + wcb[2] * bx[i + 2] + wcb[3] * bx[i + 3]; XB[(tg * 8 + i) * 72 + j] = (bf16_t)f2bf(xb[i]); }
        LDS_BARRIER();
        if (w + wstep < wend) MIX1_ISSUE(w + wstep);
        {
            f32x16 acc;
#pragma unroll
            for (int i = 0; i < 16; ++i) acc[i] = 0.f;
#pragma unroll
            for (int ks = 0; ks < 4; ++ks) {
                const bf16x8v av = *(const LAS bf16x8v*)(XB + (mtb * 32 + mr) * 72 + ks * 16 + 8 * mh);
                const bf16x8v bv = *(const LAS bf16x8v*)(WT + mg * 64 * 72 + (mjb * 32 + mr) * 72 + ks * 16 + 8 * mh);
                acc = __builtin_amdgcn_mfma_f32_32x32x16_bf16(av, bv, acc, 0, 0, 0);
            }
#pragma unroll
            for (int i = 0; i < 16; ++i) PRE[(mg * 64 + mtb * 32 + (i & 3) + 8 * (i >> 2) + 4 * mh) * 64 + mjb * 32 + mr] = acc[i];
        }
        LDS_BARRIER();
        float hl[8], ac[8]; float Ac = 1.f, hc = 0.f;
#pragma unroll
        for (int t = 0; t < 8; ++t) {
            if (tg * 8 + t < len) {
                const float r = sigm(br + PRE[(tg * 8 + t) * 64 + j]), ig = sigm(bi + PRE[(64 + tg * 8 + t) * 64 + j]);
                const float la = 8.0f * r * lsig, av = __expf(la);
                const float bt = __builtin_amdgcn_sqrtf(fmaxf(1.0f - av * av, 0.f)) * ig * xb[t];
                hc = av * hc + bt; Ac *= av;
            }
            hl[t] = hc; ac[t] = Ac;
        }
        comb[(tg * 2 + 0) * 64 + j] = Ac; comb[(tg * 2 + 1) * 64 + j] = hc;
        LDS_BARRIER();
        float Ap = 1.f, Hp = 0.f;
        for (int g = 0; g < tg; ++g) { const float Ag = comb[(g * 2) * 64 + j], Hg = comb[(g * 2 + 1) * 64 + j]; Hp = Ag * Hp + Hg; Ap *= Ag; }
#pragma unroll
        for (int t = 0; t < 8; ++t) {
            if (tg * 8 + t < len) HLAC[(size_t)(row0 + tg * 8 + t) * DB + chg] = pk2(hl[t] + ac[t] * Hp, ac[t] * Ap);
        }
        if (tg == 7) { AGG[((size_t)chunk * 2 + 0) * DB + chg] = ac[7] * Ap; AGG[((size_t)chunk * 2 + 1) * DB + chg] = hl[7] + ac[7] * Hp; }
        LDS_BARRIER();
    }
#undef MIX1_ISSUE
#undef MIX1_CONSUME
}

__device__ __forceinline__ void phase_mix2(CArgs a, LAS unsigned char* lds, int l, int tid, int lane, int wave) {
    unsigned char* ws = a->ws;
    const bf16_t* U = (const bf16_t*)(ws + WS_GU); bf16_t* Y = (bf16_t*)(ws + WS_Y);
    const unsigned* HLAC = (const unsigned*)(ws + WS_HL); const float* AGG = (const float*)(ws + WS_AGG);
    LAS float* vs = (LAS float*)lds;
    LAS float* carry = vs + 62 * 256;
    const int c4 = 4 * lane, c8 = 8 * lane;
    LAS float* wcs = carry + 512;
    for (int e = tid; e < 31 * 64; e += NTHR) *(LAS f32x4*)(wcs + 4 * e) = *(const f32x4*)(a->in[I_WCC] + (size_t)l * 31 * DC + 4 * e);
    const float* bccp = a->in[I_BCC] + l * DC + c4; const float* lngp = a->in[I_LNG] + l * DC + c4; const float* lnbp = a->in[I_LNB] + l * DC + c4;
    const float* grp = a->in[I_GRP] + l * D;
    const float* wap = a->in[I_WCA] + (size_t)l * 3 * DA + c4;
    for (int unit = blockIdx.x; unit < 256 + NSB; unit += gridDim.x)
    for (int half = 0; half < (unit < 256 ? 2 : 1); ++half) {
        int row0, len, t0, sb = -1; bool islast;
        if (unit >= 256) { sb = unit - 256; row0 = TP + TSS * sb; len = TSS; t0 = 0; islast = true; }
        else { const int pi = 2 * unit + half; row0 = 32 * pi; len = 32; t0 = row0; islast = (pi == 511); }
        float* o_ca = a->out + (sb < 0 ? O_CAP + (size_t)l * 2 * DA : O_CAS + (size_t)(l * NSB + sb) * 2 * DA);
        float* o_cb = a->out + (sb < 0 ? O_CBP + (size_t)l * 3 * DB : O_CBS + (size_t)(l * NSB + sb) * 3 * DB);
        float* o_h  = a->out + (sb < 0 ? O_HP + (size_t)l * DB : O_HS + (size_t)(l * NSB + sb) * DB);
        float* o_cc = a->out + (sb < 0 ? O_CCP + (size_t)l * 30 * DC : O_CCS + (size_t)(l * NSB + sb) * 30 * DC);
        if (sb < 0 && t0 >= 30) {
            u32x2 cvr[8], cgr[8];
#pragma unroll
            for (int u = 0; u < 8; ++u) { const int e = tid + NTHR * u;
                if (e < 62 * 64) { const bf16_t* ur = U + (size_t)(row0 - 30 + (e >> 6)) * DIN + 4 * (e & 63); cvr[u] = *(const u32x2*)(ur + COL_CV); cgr[u] = *(const u32x2*)(ur + COL_CG); } }
#pragma unroll
            for (int u = 0; u < 8; ++u) { const int e = tid + NTHR * u;
                if (e < 62 * 64) { f32x4 v; v[0] = bflo(cvr[u].x) * sigm(bflo(cgr[u].x)); v[1] = bfhi(cvr[u].x) * sigm(bfhi(cgr[u].x)); v[2] = bflo(cvr[u].y) * sigm(bflo(cgr[u].y)); v[3] = bfhi(cvr[u].y) * sigm(bfhi(cgr[u].y));
                    *(LAS f32x4*)(vs + 4 * e) = v; } }
        } else
        for (int e = tid; e < (len + 30) * 64; e += NTHR) {
            const int i = e >> 6, q = e & 63, tt = t0 - 30 + i;
            f32x4 v = (f32x4){0.f, 0.f, 0.f, 0.f};
            if (tt >= 0) {
                const bf16_t* ur = U + (size_t)(row0 - 30 + i) * DIN;
                const f32x4 cv = ld_bf4(ur + COL_CV + 4 * q), cg_ = ld_bf4(ur + COL_CG + 4 * q);
#pragma unroll
                for (int z = 0; z < 4; ++z) v[z] = cv[z] * sigm(cg_[z]);
            } else if (sb >= 0) v = *(const f32x4*)(a->in[I_SC] + ((size_t)(l * NSB + sb) * 30 + (30 + tt)) * DC + 4 * q);
            *(LAS f32x4*)(vs + i * 256 + 4 * q) = v;
        }
        if (half == 0) {
            float hc;
            if (sb >= 0) hc = a->in[I_SH][(size_t)(l * NSB + sb) * DB + tid];
            else { hc = 0.f; const int nch = unit;
                int k = 0;
                for (; k + 32 <= nch; k += 32) { float A[32], B[32];
#pragma unroll
                    for (int q = 0; q < 32; ++q) { A[q] = AGG[((size_t)(k + q) * 2) * DB + tid]; B[q] = AGG[((size_t)(k + q) * 2 + 1) * DB + tid]; }
#pragma unroll
                    for (int q = 0; q < 32; ++q) hc = A[q] * hc + B[q]; }
                for (; k + 4 <= nch; k += 4) { float A[4], B[4];
#pragma unroll
                    for (int q = 0; q < 4; ++q) { A[q] = AGG[((size_t)(k + q) * 2) * DB + tid]; B[q] = AGG[((size_t)(k + q) * 2 + 1) * DB + tid]; }
#pragma unroll
                    for (int q = 0; q < 4; ++q) hc = A[q] * hc + B[q]; }
                for (; k < nch; ++k) { const float A = AGG[((size_t)k * 2) * DB + tid], B = AGG[((size_t)k * 2 + 1) * DB + tid]; hc = A * hc + B; } }
            carry[tid] = hc;
        }
        LDS_BARRIER();
        const int i0 = 4 * wave;
        if (i0 < len) {
            const int rb = row0 + i0, tb = t0 + i0;
            const bf16_t* ub = U + (size_t)rb * DIN;
            f32x4 acc[4];
#pragma unroll
            for (int j = 0; j < 4; ++j) acc[j] = *(const f32x4*)bccp;
            {
                const f32x4 z4 = (f32x4){0.f, 0.f, 0.f, 0.f};
                f32x4 pw1 = z4, pw2 = z4, pw3 = z4;
#pragma unroll 1
                for (int q = 0; q < 8; ++q) {
                    const LAS float* wp = wcs + (4 * q) * 256 + c4; const LAS float* vp = vs + (i0 + 4 * q) * 256 + c4;
                    const f32x4 w0 = *(const LAS f32x4*)(wp), w1 = *(const LAS f32x4*)(wp + 256), w2 = *(const LAS f32x4*)(wp + 512), w3 = q < 7 ? *(const LAS f32x4*)(wp + 768) : z4;
                    const f32x4 v0 = *(const LAS f32x4*)(vp), v1 = *(const LAS f32x4*)(vp + 256), v2 = *(const LAS f32x4*)(vp + 512), v3 = *(const LAS f32x4*)(vp + 768);
                    acc[0] += w0 * v0; acc[1] += pw3 * v0; acc[2] += pw2 * v0; acc[3] += pw1 * v0;
                    acc[0] += w1 * v1; acc[1] += w0 * v1;  acc[2] += pw3 * v1; acc[3] += pw2 * v1;
                    acc[0] += w2 * v2; acc[1] += w1 * v2;  acc[2] += w0 * v2;  acc[3] += pw3 * v2;
                    acc[0] += w3 * v3; acc[1] += w2 * v3;  acc[2] += w1 * v3;  acc[3] += w0 * v3;
                    pw1 = w1; pw2 = w2; pw3 = w3;
                }
                const f32x4 v32 = *(const LAS f32x4*)(vs + (i0 + 32) * 256 + c4), v33 = *(const LAS f32x4*)(vs + (i0 + 33) * 256 + c4);
                acc[2] += pw2 * v32; acc[3] += pw1 * v32; acc[3] += pw2 * v33;
            }
            f32x4 pr[6];
#pragma unroll
            for (int m = 0; m < 6; ++m) {
                const int tq = tb - 2 + m;
                if (tq >= 0) { const bf16_t* uq = U + (size_t)(rb - 2 + m) * DIN; pr[m] = ld_bf4(uq + COL_AC + c4) * ld_bf4(uq + COL_AX + c4); }
                else if (sb >= 0) pr[m] = *(const f32x4*)(a->in[I_SA] + ((size_t)(l * NSB + sb) * 2 + (2 + tq)) * DA + c4);
                else pr[m] = (f32x4){0.f, 0.f, 0.f, 0.f};
            }
            u32x2 abr[4];
#pragma unroll
            for (int j = 0; j < 4; ++j) abr[j] = *(const u32x2*)(ub + (size_t)j * DIN + COL_AB + c4);
            u32x4 ha0[4], ha1[4], bgr[4];
#pragma unroll
            for (int j = 0; j < 4; ++j) { ha0[j] = *(const u32x4*)(HLAC + (size_t)(rb + j) * DB + c8); ha1[j] = *(const u32x4*)(HLAC + (size_t)(rb + j) * DB + c8 + 4);
                bgr[j] = *(const u32x4*)(ub + (size_t)j * DIN + COL_BG + c8); }
            f32x4 ya[4], y0[4], y1[4];
            const f32x4 wa0 = *(const f32x4*)wap, wa1 = *(const f32x4*)(wap + DA), wa2 = *(const f32x4*)(wap + 2 * DA);
#pragma unroll
            for (int j = 0; j < 4; ++j) {
                ya[j] = (f32x4){bflo(abr[j].x), bfhi(abr[j].x), bflo(abr[j].y), bfhi(abr[j].y)} * (wa0 * pr[j] + wa1 * pr[j + 1] + wa2 * pr[j + 2]);
                const f32x4 hl0 = (f32x4){bflo(ha0[j].x), bflo(ha0[j].y), bflo(ha0[j].z), bflo(ha0[j].w)}, hl1 = (f32x4){bflo(ha1[j].x), bflo(ha1[j].y), bflo(ha1[j].z), bflo(ha1[j].w)};
                const f32x4 ac0 = (f32x4){bfhi(ha0[j].x), bfhi(ha0[j].y), bfhi(ha0[j].z), bfhi(ha0[j].w)}, ac1 = (f32x4){bfhi(ha1[j].x), bfhi(ha1[j].y), bfhi(ha1[j].z), bfhi(ha1[j].w)};
                const f32x4 h0 = hl0 + ac0 * *(const LAS f32x4*)(carry + c8), h1 = hl1 + ac1 * *(const LAS f32x4*)(carry + c8 + 4);
                const f32x4 g0 = (f32x4){bflo(bgr[j].x), bfhi(bgr[j].x), bflo(bgr[j].y), bfhi(bgr[j].y)}, g1 = (f32x4){bflo(bgr[j].z), bfhi(bgr[j].z), bflo(bgr[j].w), bfhi(bgr[j].w)};
#pragma unroll
                for (int z = 0; z < 4; ++z) { y0[j][z] = h0[z] * gelu_tanh(g0[z]); y1[j][z] = h1[z] * gelu_tanh(g1[z]); }
                if (islast && i0 + j == len - 1) { *(f32x4*)(o_h + c8) = h0; *(f32x4*)(o_h + c8 + 4) = h1; }
            }
            float sC[4], qC[4], qA[4], qB[4];
#pragma unroll
            for (int j = 0; j < 4; ++j) { sC[j] = hsum4(acc[j]); qC[j] = hsq4(acc[j]); qA[j] = hsq4(ya[j]); qB[j] = hsq4(y0[j]) + hsq4(y1[j]); }
#pragma unroll
            for (int hh = 0; hh < 2; ++hh) {
#pragma unroll
                for (int o = 1; o < 64; o <<= 1) { const int idx = (lane ^ o) << 2;
                    float t1[2], t2[2], t3[2], t4[2];
#pragma unroll
                    for (int j = 0; j < 2; ++j) { const int jj = 2 * hh + j;
                        t1[j] = __builtin_bit_cast(float, __builtin_amdgcn_ds_bpermute(idx, __builtin_bit_cast(int, sC[jj]))); t2[j] = __builtin_bit_cast(float, __builtin_amdgcn_ds_bpermute(idx, __builtin_bit_cast(int, qC[jj])));
                        t3[j] = __builtin_bit_cast(float, __builtin_amdgcn_ds_bpermute(idx, __builtin_bit_cast(int, qA[jj]))); t4[j] = __builtin_bit_cast(float, __builtin_amdgcn_ds_bpermute(idx, __builtin_bit_cast(int, qB[jj]))); }
#pragma unroll
                    for (int j = 0; j < 2; ++j) { const int jj = 2 * hh + j; sC[jj] += t1[j]; qC[jj] += t2[j]; qA[jj] += t3[j]; qB[jj] += t4[j]; } }
            }
            float qY[4];
            const f32x4 lng = *(const f32x4*)lngp, lnb = *(const f32x4*)lnbp;
#pragma unroll
            for (int j = 0; j < 4; ++j) {
                const float mu = sC[j] * (1.0f / DC), var = fmaxf(qC[j] * (1.0f / DC) - mu * mu, 0.f);
                f32x4 y = (acc[j] - mu) * __builtin_amdgcn_rsqf(var + EPS) * lng + lnb;
#pragma unroll
                for (int z = 0; z < 4; ++z) y[z] = y[z] * sigm(y[z]);
                acc[j] = y; qY[j] = hsq4(y);
            }
            wave_sum4_l(qY[0], qY[1], qY[2], qY[3], lane);
            const f32x4 gA = *(const f32x4*)(grp + c4), gC = *(const f32x4*)(grp + 768 + c4), gB0 = *(const f32x4*)(grp + 256 + c8), gB1 = *(const f32x4*)(grp + 256 + c8 + 4);
#pragma unroll
            for (int j = 0; j < 4; ++j) {
                const int i = i0 + j;
                bf16_t* yr = Y + (size_t)(rb + j) * D;
                { const f32x4 y = acc[j] * (__builtin_amdgcn_rsqf(qY[j] * (1.0f / DC) + EPS)) * gC; u32x2 o; o.x = pk2(y[0], y[1]); o.y = pk2(y[2], y[3]); *(u32x2*)(yr + 768 + c4) = o; }
                { const f32x4 y = ya[j] * (__builtin_amdgcn_rsqf(qA[j] * (1.0f / DA) + EPS)) * gA; u32x2 o; o.x = pk2(y[0], y[1]); o.y = pk2(y[2], y[3]); *(u32x2*)(yr + c4) = o; }
                { const float rs = __builtin_amdgcn_rsqf(qB[j] * (1.0f / DB) + EPS); const f32x4 a0 = y0[j] * rs * gB0, a1 = y1[j] * rs * gB1;
                  u32x4 o; o.x = pk2(a0[0], a0[1]); o.y = pk2(a0[2], a0[3]); o.z = pk2(a1[0], a1[1]); o.w = pk2(a1[2], a1[3]); *(u32x4*)(yr + 256 + c8) = o; }
                if (islast) {
                    if (i >= len - 2) *(f32x4*)(o_ca + (size_t)(i - (len - 2)) * DA + c4) = pr[j + 2];
                    if (i >= len - 3) { const bf16_t* ur = ub + (size_t)j * DIN; float* ob = o_cb + (size_t)(i - (len - 3)) * DB + c8; *(f32x4*)ob = ld_bf4(ur + COL_BX + c8); *(f32x4*)(ob + 4) = ld_bf4(ur + COL_BX + c8 + 4); }
                }
            }
        }
        if (islast) {
            for (int e = tid; e < 30 * 64; e += NTHR) { const int i = e >> 6, q = e & 63; *(f32x4*)(o_cc + (size_t)i * DC + 4 * q) = *(const LAS f32x4*)(vs + (len + i) * 256 + 4 * q); }
        }
        LDS_BARRIER();
    }
}

#define XB_TMO      128
#define XB_XCNT(j)  (256  + 64 * (j))
#define XB_XSUB(j)  (1280 + 64 * (j))
#define XB_XGEN(j)  (2304 + 64 * (j))
#define XB_TOP      3328
#define XB_TOPGEN   3392
#define XCD_BAR_WORDS 3456
#define XB_SPIN_CAP (1u << 18)

__device__ __forceinline__ unsigned xb_ld(unsigned* p)              { return __hip_atomic_load(p, __ATOMIC_RELAXED, __HIP_MEMORY_SCOPE_AGENT); }
__device__ __forceinline__ unsigned xb_add(unsigned* p, unsigned v) { return __hip_atomic_fetch_add(p, v, __ATOMIC_RELAXED, __HIP_MEMORY_SCOPE_AGENT); }
__device__ __forceinline__ unsigned xb_xcc_id() { return (unsigned)__builtin_amdgcn_s_getreg((3 << 11) | 20) & 0xFu; }
#define XB_SPIN(cond, bar) do { unsigned _sp = 0; while (cond) { __builtin_amdgcn_s_sleep(1); \
    if ((++_sp & 255u) == 0u) { if (xb_ld(&(bar)[XB_TMO])) break; if (_sp > XB_SPIN_CAP) { atomicAdd(&(bar)[XB_TMO], 1u); break; } } } } while (0)

struct XcdBarrier {
    unsigned* bar; unsigned x;
    volatile LAS unsigned* st;
};

__device__ __forceinline__ XcdBarrier xcd_barrier_post(unsigned* bar, volatile LAS unsigned* st) {
    XcdBarrier b; b.bar = bar; b.x = xb_xcc_id(); b.st = st;
    if (threadIdx.x == 0) (void)xb_add(&bar[XB_XCNT(b.x)], 1u);
    return b;
}
__device__ __forceinline__ void xcd_barrier_complete(unsigned* bar, unsigned x, unsigned& nloc, unsigned& nx) {
    const unsigned G = gridDim.x * gridDim.y * gridDim.z;
    unsigned sum, cnt, mine, sp = 0u;
    for (;;) {
        sum = 0u; cnt = 0u; mine = 0u;
#pragma unroll
        for (unsigned j = 0; j < 16; ++j) { const unsigned c = xb_ld(&bar[XB_XCNT(j)]); sum += c; cnt += (c > 0u) ? 1u : 0u; mine = (j == x) ? c : mine; }
        if (sum == G) break;
        __builtin_amdgcn_s_sleep(1);
        if ((++sp & 255u) == 0u) { if (xb_ld(&bar[XB_TMO])) break; if (sp > XB_SPIN_CAP) { atomicAdd(&bar[XB_TMO], 1u); break; } }
    }
    nloc = mine > 0u ? mine : 1u; nx = cnt > 0u ? cnt : 1u;
}

__device__ __forceinline__ void xcd_barrier(const XcdBarrier& b) {
    asm volatile("s_waitcnt vmcnt(0)" ::: "memory");
    __syncthreads();
    if (threadIdx.x == 0) {
        unsigned* bar = b.bar;
        __builtin_amdgcn_s_waitcnt(0);
        unsigned nloc = b.st[0], nx = b.st[1];
        if (nloc == 0u) { xcd_barrier_complete(bar, b.x, nloc, nx); b.st[0] = nloc; b.st[1] = nx; }
        const unsigned old = xb_add(&bar[XB_XSUB(b.x)], 1u);
        const unsigned gen = old / nloc;
        if (old + 1u == (gen + 1u) * nloc) {
            __builtin_amdgcn_fence(__ATOMIC_RELEASE, "agent");
            asm volatile("s_waitcnt vmcnt(0)" ::: "memory");
            const unsigned og = xb_add(&bar[XB_TOP], 1u);
            const unsigned tg = og / nx;
            if (og + 1u == (tg + 1u) * nx) xb_add(&bar[XB_TOPGEN], 1u);
            else XB_SPIN(xb_ld(&bar[XB_TOPGEN]) == tg, bar);
            __builtin_amdgcn_fence(__ATOMIC_ACQUIRE, "agent");
            xb_add(&bar[XB_XGEN(b.x)], 1u);
            asm volatile("s_waitcnt vmcnt(0)" ::: "memory");
        } else {
            XB_SPIN(xb_ld(&bar[XB_XGEN(b.x)]) == gen, bar);
            __builtin_amdgcn_fence(__ATOMIC_ACQUIRE, "agent");
            asm volatile("s_waitcnt vmcnt(0)" ::: "memory");
        }
    }
    __syncthreads();
}

__global__ void __launch_bounds__(NTHR, 2) fwd_kernel(Args a_val) {
    extern __shared__ __attribute__((aligned(16))) unsigned char lds_raw[];
    LAS unsigned char* lds = (LAS unsigned char*)lds_raw;
    unsigned char* ws = a_val.ws;
    volatile LAS unsigned* bst = (volatile LAS unsigned*)(lds + 131072 + 64);
    if (threadIdx.x < 2) bst[threadIdx.x] = 0u;
    __syncthreads();
    const XcdBarrier bar = xcd_barrier_post((unsigned*)ws, bst);
    const float* mod = (const float*)(ws + WS_MOD);
    const int G = gridDim.x;
    for (int step = a_val.ph_lo; step < a_val.ph_hi; ++step) {
        int ph = step;
#if MK_PROBE == 4
        ph = step == 0 ? 0 : step - 1;
#elif MK_PROBE == 2 || MK_PROBE == 3 || MK_PROBE == 5 || MK_PROBE == 6
        if (step >= 2) {
            constexpr unsigned long long TAB = MK_PROBE == 2 ? 0xA98765443210ull : MK_PROBE == 3 ? 0xA98765543210ull : MK_PROBE == 5 ? 0xA9887654332100ull : 0xA9987665432110ull;
            constexpr int LSTEPS = (MK_PROBE == 2 || MK_PROBE == 3) ? 12 : 14;
            const int ls = (step - 2) / LSTEPS, s = (step - 2) % LSTEPS;
            ph = 2 + 11 * ls + (int)((TAB >> (4 * s)) & 15ull);
        }
#endif
        CArgs a = (CArgs)__builtin_amdgcn_kernarg_segment_ptr(); asm volatile("" : "+s"(a));
        int tid = threadIdx.x; asm volatile("" : "+v"(tid));
        const int lane = tid & 63, wave = __builtin_amdgcn_readfirstlane(tid >> 6);
        if (ph == 0) { if (!MK_NO_PRO) phase_prologue(a, lds, tid, lane, wave); }
        else if (ph == 1) phase_rows(a, lane, wave, 0, false, 0.f, 1, mod, 0, a->in[I_NPOST], mod, 1, 0, a->in[I_NPRE]);
        else {
            const int l = (ph - 2) / 11, k = (ph - 2) % 11;
            const float* modl = mod + (size_t)l * 9 * 9216;
            const bool defer_win = (G == 256) && MK_DEFER_WIN;
            if (k == 0 || k == 8 || k == 1 || k == 9 || k == 6 || k == 3 || (k == 4 && defer_win)) {
                pg8::Gemm g; pg8::EpiMulti E; int N;
                const bool n1024 = (k == 1 || k == 6 || k == 9);
                if (k == 0 || k == 8) {
                    g = pg8::Gemm{(const bf16_t*)(ws + WS_H), (const bf16_t*)(ws + WS_W13 + (size_t)(l * 2 + (k == 0 ? 0 : 1)) * W13_BYTES), MP, 2 * DFF, D, D};
                    E = pg8::EpiMulti{0, (void*)(ws + WS_GU), DFF, nullptr}; N = 2 * DFF;
                } else if (k == 6) {
                    g = pg8::Gemm{(const bf16_t*)(ws + WS_Y), (const bf16_t*)(ws + WS_WOUT + (size_t)l * WOUT_BYTES), MP, D, D, D};
                    E = pg8::EpiMulti{2, (void*)(ws + WS_F), D, (void*)(ws + WS_FPART)}; N = D;
                } else if (k == 3 || k == 4) {
                    g = pg8::Gemm{(const bf16_t*)(ws + WS_H), (const bf16_t*)(ws + WS_WIN + (size_t)l * WIN_BYTES), MP, DIN, D, D};
                    E = pg8::EpiMulti{2, (void*)(ws + WS_GU), DIN, nullptr}; N = DIN;
                } else {
                    g = pg8::Gemm{(const bf16_t*)(ws + WS_GU), (const bf16_t*)(ws + WS_W2 + (size_t)(l * 2 + (k == 1 ? 0 : 1)) * W2_BYTES), MP, D, DFF, DFF};
                    E = pg8::EpiMulti{2, (void*)(ws + WS_F), D, (void*)(ws + WS_FPART)}; N = D;
                }
                const bool stream_tail = n1024 && (G == 256) && MK_STREAM_TAIL;
                const int nparts = (n1024 && !stream_tail) ? 2 : 1;
                for (int part = 0; part < nparts; ++part) {
                    pg8::StaticOrder S;
                    if (k == 3 && defer_win) { S.init(MP, 7 * 256, G, (int)blockIdx.x); S.mode = 1; }
                    else if (k == 4) { S.init(MP, N, G, (int)blockIdx.x - 176); S.mode = 2; }
                    else if (!n1024) S.init(MP, N, G, (int)blockIdx.x);
                    else if (stream_tail) { S.init(TP, N, G, (int)blockIdx.x, 0, 1, 256); S.mode = 3; S.pmx = TP / 256; S.xsplit = g.ld / 256; }
                    else if (part == 0) S.init(TP, N, G, (int)blockIdx.x);
                    else { S.init(256, N, G, (int)blockIdx.x, TP / 256, g.ld / 256, 256); g.K = 256; E = pg8::EpiMulti{4, (void*)(ws + WS_FPART), D, nullptr}; }
                    if (!MK_NO_G1) pg8::gemm_phase<pg8::EpiMulti, pg8::StaticOrder, true, true>(lds, g, S, E);
                }
            }
            if (k == 4) { if (!MK_NO_MIX1) phase_mix1(a, lds, l, tid, lane, wave, defer_win); }
            else if (k == 0 || k == 8 || k == 1 || k == 9 || k == 6 || k == 3) { }
            else if (k == 5) { if (!MK_NO_MIX2) phase_mix2(a, lds, l, tid, lane, wave); }
            else {
                const int sub = k == 2 ? 0 : (k == 7 ? 1 : 2);
                const bool fin = (k == 10 && l == NL - 1);
                const int ln = k == 10 ? (l + 1 < NL ? l + 1 : l) : l, subn = k == 10 ? 0 : sub + 1;
                phase_rows(a, lane, wave, 1, fin, sub == 1 ? 1.0f : 0.5f, sub == 1 ? D / 256 : DFF / 256, modl, 3 * sub + 2, a->in[I_NPOST] + (size_t)(l * 3 + sub) * D,
                           mod + (size_t)ln * 9 * 9216, 3 * subn + 1, 3 * subn, a->in[I_NPRE] + (size_t)(ln * 3 + subn) * D);
            }
        }
        if (step + 1 < a_val.ph_hi) xcd_barrier(bar);
#if MK_PROBE == 1
        if (step + 1 < a_val.ph_hi) xcd_barrier(bar);
#endif
        if (a_val.ph_hi == -12345) cg::this_grid().sync();
    }
}

#if MK_CHECK
__device__ __forceinline__ float wsum(float v) { for (int o = 32; o > 0; o >>= 1) v += __shfl_xor(v, o); return v; }
__device__ __forceinline__ float bfv(const bf16_t* p) { return __builtin_bit_cast(float, (unsigned)(*p) << 16); }
__device__ __forceinline__ bool isbad(float got, float ref, float rel, float ab) { const float d = fabsf(got - ref); return !(d <= ab + rel * fabsf(ref)); }
__device__ __forceinline__ void fail(unsigned* w, unsigned code) { atomicMin(w, code); }
__device__ float dotA(const bf16_t* Arow, const float* W, int K, int N, int c, int lane) { float s = 0.f; for (int k = lane; k < K; k += 64) s += bfv(Arow + k) * W[(size_t)k * N + c]; return wsum(s); }
__device__ int chk_row(int i) { const int R[6] = {0, 300, 16383, 16384, 16400, 16511}; return i == 0 ? 0 : i == 1 ? 300 : i == 2 ? 16383 : i == 3 ? 16384 : i == 4 ? 16400 : 16511; }
__global__ void chk_kernel(Args a, int stage) {
    const int lane = threadIdx.x, s = blockIdx.x;
    unsigned char* ws = a.ws; unsigned* word = (unsigned*)(ws + 32768);
    const float* mod = (const float*)(ws + WS_MOD);
    const float* Xb = (const float*)(ws + WS_X); const bf16_t* H = (const bf16_t*)(ws + WS_H); const bf16_t* Fb = (const bf16_t*)(ws + WS_F);
    const bf16_t* GU = (const bf16_t*)(ws + WS_GU); const bf16_t* Y = (const bf16_t*)(ws + WS_Y);
    const int r = chk_row(s % 6), bidx = r < TP ? 0 : 1 + ((r - TP) >> 4);
    const int cs = s / 6;
    if (stage == 1) {
        { const int b = (s * 3) % 9, n = (s * 1531 + 7) % 9216; float acc = 0.f;
          for (int k = lane; k < 1024; k += 64) { const float c = b == 0 ? a.in[I_CP][k] : a.in[I_CS][(b - 1) * 1024 + k]; acc += c / (1.f + expf(-c)) * a.in[I_WADA][(size_t)k * 9216 + n]; }
          acc = wsum(acc) + a.in[I_BADA][n];
          const float got = mod[(size_t)b * 9216 + n], d = fabsf(got - acc);
          if (isbad(got, acc, 1e-3f, 1e-3f)) fail(word, 1); }
        { const int c = (s * 401 + 130) % DFF, row = (c >> 7) * 256 + (c & 127); const bf16_t* WT = (const bf16_t*)(ws + WS_W13);
          for (int k = lane; k < 1024; k += 64) { if (isbad(bfv(WT + (size_t)row * 1024 + k), a.in[I_W1][(size_t)k * DFF + c], 0.01f, 1e-6f)) fail(word, 2);
                                                  if (isbad(bfv(WT + (size_t)(row + 128) * 1024 + k), a.in[I_W3][(size_t)k * DFF + c], 0.01f, 1e-6f)) fail(word, 3); } }
        { const int c = (s * 211 + 513) % D; const bf16_t* WT = (const bf16_t*)(ws + WS_W2);
          for (int k = lane; k < DFF; k += 64) if (isbad(bfv(WT + (size_t)c * DFF + k), a.in[I_W2][(size_t)k * D + c], 0.01f, 1e-6f)) fail(word, 4); }
        { const int c = (s * 577 + 2303) % DIN; const bf16_t* WT = (const bf16_t*)(ws + WS_WIN);
          for (int k = lane; k < D; k += 64) if (isbad(bfv(WT + (size_t)c * D + k), a.in[I_WIN][(size_t)k * DIN + c], 0.01f, 1e-6f)) fail(word, 5); }
        { const int c = (s * 311 + 1023) % D; const bf16_t* WT = (const bf16_t*)(ws + WS_WOUT);
          for (int k = lane; k < D; k += 64) if (isbad(bfv(WT + (size_t)c * D + k), a.in[I_WOUT][(size_t)k * D + c], 0.01f, 1e-6f)) fail(word, 6); }
        { const int c = (s * 401 + 130) % DFF, row = (c >> 7) * 256 + (c & 127); const bf16_t* WT = (const bf16_t*)(ws + WS_W13 + 7 * W13_BYTES);
          for (int k = lane; k < 1024; k += 64) if (isbad(bfv(WT + (size_t)(row + 128) * 1024 + k), a.in[I_W3][(size_t)7 * D * DFF + (size_t)k * DFF + c], 0.01f, 1e-6f)) fail(word, 7); }
    } else if (stage == 2 || stage == 5 || stage == 9) {
        const float* xin = r < TP ? a.in[I_XP] + (size_t)r * D : a.in[I_XS] + (size_t)(r - TP) * D;
        float ssx = 0.f;
        for (int c = lane; c < D; c += 64) ssx += Xb[(size_t)r * D + c] * Xb[(size_t)r * D + c];
        const float rstdx = 1.f / sqrtf(wsum(ssx) / D + EPS);
        if (stage == 2) { for (int c = lane; c < D; c += 64) if (isbad(Xb[(size_t)r * D + c], xin[c], 1e-6f, 1e-6f)) fail(word, 8); }
        if (stage == 5) { float ssf = 0.f; for (int c = lane; c < D; c += 64) { const float f = bfv(Fb + (size_t)r * D + c); ssf += f * f; }
            const float rstdf = 1.f / sqrtf(wsum(ssf) / D + EPS);
            for (int c = lane; c < D; c += 64) { const float ref = xin[c] + 0.5f * mod[((size_t)bidx * 9 + 2) * D + c] * bfv(Fb + (size_t)r * D + c) * rstdf * a.in[I_NPOST][c];
                if (isbad(Xb[(size_t)r * D + c], ref, 1e-3f, 1e-3f)) fail(word, 11); } }
        const int sub = stage == 2 ? 0 : (stage == 5 ? 1 : 2);
        for (int c = lane; c < D; c += 64) { const float ref = Xb[(size_t)r * D + c] * rstdx * a.in[I_NPRE][sub * D + c] * (1.f + mod[((size_t)bidx * 9 + 3 * sub + 1) * D + c]) + mod[((size_t)bidx * 9 + 3 * sub) * D + c];
            if (isbad(bfv(H + (size_t)r * D + c), ref, 0.01f, 0.01f)) fail(word, stage == 2 ? 9 : (stage == 5 ? 12 : 24)); }
    } else if (stage == 3) {
        const int c = (cs * 937 + 130 * (s % 6)) % DFF;
        const float a1 = dotA(H + (size_t)r * D, a.in[I_W1], D, DFF, c, lane), a3 = dotA(H + (size_t)r * D, a.in[I_W3], D, DFF, c, lane);
        const float ref = a1 / (1.f + expf(-a1)) * a3;
        if (isbad(bfv(GU + (size_t)r * DFF + c), ref, 0.03f, 0.03f)) fail(word, 10);
    } else if (stage == 4) {
        const int c = (cs * 341 + 513 * (s % 6)) % D;
        const float ref = dotA(GU + (size_t)r * DFF, a.in[I_W2], DFF, D, c, lane);
        if (isbad(bfv(Fb + (size_t)r * D + c), ref, 0.03f, 0.03f)) fail(word, 13);
    } else if (stage == 6) {
        const int c = (cs * 601 + 255 * (s % 6) + 1) % DIN;
        const float ref = dotA(H + (size_t)r * D, a.in[I_WIN], D, DIN, c, lane);
        if (isbad(bfv(GU + (size_t)r * DIN + c), ref, 0.03f, 0.03f)) fail(word, 14);
    } else if (stage == 8) {
        const int c = (cs * 341 + 513 * (s % 6)) % D;
        const float ref = dotA(Y + (size_t)r * D, a.in[I_WOUT], D, D, c, lane);
        if (isbad(bfv(Fb + (size_t)r * D + c), ref, 0.03f, 0.03f)) fail(word, 23);
    } else if (stage == 7) {
        if (s < 6) {
            const bool smp = s >= 3; const int sbb = s - 3;
            const int rl = smp ? TP + 16 * sbb + 15 : TP - 1;
            for (int c = lane; c < DA; c += 64) { const bf16_t* u = GU + (size_t)rl * DIN; const float ref = bfv(u + COL_AC + c) * bfv(u + COL_AX + c);
                const float got = a.out[(smp ? O_CAS + (size_t)sbb * 2 * DA : O_CAP) + DA + c]; if (isbad(got, ref, 1e-3f, 1e-4f)) fail(word, 15); }
            for (int c = lane; c < DB; c += 64) { const float ref = bfv(GU + (size_t)(rl - 2) * DIN + COL_BX + c);
                const float got = a.out[(smp ? O_CBS + (size_t)sbb * 3 * DB : O_CBP) + c]; if (isbad(got, ref, 1e-3f, 1e-4f)) fail(word, 16); }
            for (int c = lane; c < DC; c += 64) { const bf16_t* u = GU + (size_t)(rl - 3) * DIN; const float ref = bfv(u + COL_CV + c) / (1.f + expf(-bfv(u + COL_CG + c)));
                const float got = a.out[(smp ? O_CCS + (size_t)sbb * 30 * DC : O_CCP) + 26 * DC + c]; if (isbad(got, ref, 2e-3f, 1e-4f)) fail(word, 17); }
            if (smp) { for (int c = lane; c < DC; c += 64) { const float ref = a.in[I_SC][((size_t)sbb * 30 + 20) * DC + c];
                const float got = a.out[O_CCS + (size_t)sbb * 30 * DC + 4 * DC + c]; if (isbad(got, ref, 1e-5f, 1e-6f)) fail(word, 18); } }
        } else if (s < 12) {
            const int which = s - 6; const bool smp = which >= 3; const int sbb = which - 3;
            const int ch = (which * 97 + 5) % DB, head = ch >> 6, ci = 64 * head + lane;
            const int T = smp ? 16 : TP, rbase = smp ? TP + 16 * sbb : 0;
            float h = smp ? a.in[I_SH][(size_t)sbb * DB + ch] : 0.f;
            const float wrl = a.in[I_WGR][((size_t)head * 64 + lane) * 64 + (ch & 63)], wil = a.in[I_WGI][((size_t)head * 64 + lane) * 64 + (ch & 63)];
            const float lam = a.in[I_LAM][ch], lsg = -log1pf(expf(-lam));
            float xm3, xm2, xm1;
            if (smp) { xm3 = a.in[I_SB][((size_t)sbb * 3 + 0) * DB + ci]; xm2 = a.in[I_SB][((size_t)sbb * 3 + 1) * DB + ci]; xm1 = a.in[I_SB][((size_t)sbb * 3 + 2) * DB + ci]; } else { xm3 = xm2 = xm1 = 0.f; }
            const float w0 = a.in[I_WCB][0 * DB + ci], w1 = a.in[I_WCB][1 * DB + ci], w2 = a.in[I_WCB][2 * DB + ci], w3 = a.in[I_WCB][3 * DB + ci], bc = a.in[I_BCB][ci];
            float h100 = 0.f, h63 = 0.f;
            for (int t = 0; t < T; ++t) {
                const float x0 = bfv(GU + (size_t)(rbase + t) * DIN + COL_BX + ci);
                const float xb = bc + w0 * xm3 + w1 * xm2 + w2 * xm1 + w3 * x0; xm3 = xm2; xm2 = xm1; xm1 = x0;
                const float rp = wsum(xb * wrl) + a.in[I_BGR][ch], ip = wsum(xb * wil) + a.in[I_BGI][ch];
                const float xbc = __shfl(xb, ch & 63);
                const float rr = 1.f / (1.f + expf(-rp)), ii = 1.f / (1.f + expf(-ip));
                const float la = 8.f * rr * lsg, av = expf(la);
                h = av * h + sqrtf(-expm1f(2.f * la)) * ii * xbc;
                if (t == 63) h63 = h; if (t == 100) h100 = h;
            }
            const float got = a.out[(smp ? O_HS + (size_t)sbb * DB : O_HP) + ch];
            if (isbad(got, h, 0.02f, 0.003f)) fail(word, smp ? 19 : 20);
            if (!smp) { const float* HL = (const float*)(ws + WS_HL); const float* AC = (const float*)(ws + WS_AC);
                if (isbad(HL[(size_t)63 * DB + ch], h63, 0.01f, 0.002f)) fail(word, 21);
                if (isbad(HL[(size_t)100 * DB + ch] + AC[(size_t)100 * DB + ch] * h63, h100, 0.01f, 0.002f)) fail(word, 22); }
        }
    }
}
__global__ void chk_report(Args a) { const unsigned w = *(unsigned*)(a.ws + 32768); if (w != 0x7f7f7f7fu) a.out[0] = 100.0f * (float)w; }
#endif
}

extern "C" void kernel_launch(void* const* d_in, const int* in_sizes, int n_in, void* d_out, int out_size, void* d_ws, size_t ws_size, hipStream_t stream) {
    using namespace mk;
    static int grid = 0;
    if (grid == 0) {
        if (n_in != 30 || (size_t)out_size != O_END || ws_size < WS_END) { fprintf(stderr, "kernel_launch: unexpected shapes (n_in %d out %d ws %zu)\n", n_in, out_size, ws_size); grid = -1; return; }
        int dev = 0, cus = 0, per_cu = 0;
        if (hipGetDevice(&dev) != hipSuccess || hipDeviceGetAttribute(&cus, hipDeviceAttributeMultiprocessorCount, dev) != hipSuccess) { grid = -1; return; }
        if (hipFuncSetAttribute((const void*)fwd_kernel, hipFuncAttributeMaxDynamicSharedMemorySize, LDS_BYTES) != hipSuccess) { fprintf(stderr, "kernel_launch: hipFuncSetAttribute failed\n"); grid = -1; return; }
        if (hipOccupancyMaxActiveBlocksPerMultiprocessor(&per_cu, (const void*)fwd_kernel, NTHR, LDS_BYTES) != hipSuccess || per_cu < 1) { fprintf(stderr, "kernel_launch: occupancy query gave %d\n", per_cu); per_cu = 1; }
        (void)hipGetLastError();
        grid = cus * 1;
    }
    if (grid < 0) return;
    if (hipMemsetAsync(d_ws, 0, 16384, stream) != hipSuccess) { fprintf(stderr, "kernel_launch: memset failed\n"); return; }
    Args a{};
    for (int i = 0; i < 30; ++i) a.in[i] = (const float*)d_in[i];
    a.out = (float*)d_out; a.ws = (unsigned char*)d_ws;
#if MK_ONE_LAUNCH
    a.ph_lo = 0; a.ph_hi = NSTEP;
    void* args[] = {&a};
    hipError_t e = hipLaunchCooperativeKernel((const void*)fwd_kernel, dim3(grid), dim3(NTHR), args, LDS_BYTES, stream);
    if (e != hipSuccess) fprintf(stderr, "kernel_launch: cooperative launch failed: %s (grid %d)\n", hipGetErrorString(e), grid);
#else
#if MK_CHECK
    hipMemsetAsync((char*)d_ws + 32768, 0x7f, 256, stream);
#endif
    for (int ph = 0; ph < NPH; ++ph) {
        a.ph_lo = ph; a.ph_hi = ph + 1;
        hipLaunchKernelGGL(fwd_kernel, dim3(grid), dim3(NTHR), LDS_BYTES, stream, a);
#if MK_CHECK
        const int stg = ph == 0 ? 1 : ph == 1 ? 2 : ph == 2 ? 3 : ph == 3 ? 4 : ph == 4 ? 5 : ph == 5 ? 6 : ph == 7 ? 7 : ph == 8 ? 8 : ph == 9 ? 9 : 0;
        if (stg) hipLaunchKernelGGL(chk_kernel, dim3(24), dim3(64), 0, stream, a, stg);
#endif
    }
#if MK_CHECK
    hipLaunchKernelGGL(chk_report, dim3(1), dim3(1), 0, stream, a);
#endif
#endif
}
```

```cpp
#include <hip/hip_runtime.h>
#include <hip/hip_cooperative_groups.h>
#include <cstdio>
#include <cstdint>
namespace cg = cooperative_groups;
namespace pg8 {
#define PG8_LAS __attribute__((address_space(3)))
typedef unsigned short bf16_t;
typedef short bf16x8 __attribute__((ext_vector_type(8)));
typedef float f32x4 __attribute__((ext_vector_type(4)));
typedef unsigned u32x4 __attribute__((ext_vector_type(4)));
constexpr int BM = 256, BK = 64, HALF = 128, HTB = HALF * BK * 2  , STAGE_BYTES = 8 * HTB, NXCD = 8, WGM = 8;

__host__ __device__ __forceinline__ int lds_byte(int r, int c) { const int st = (r >> 4) * 2 + (c >> 5), rr = r & 15, cc = c & 31, ob = rr * 64 + cc * 2; return st * 1024 + (ob ^ (((ob >> 9) & 1) << 5)); }
__host__ __device__ __forceinline__ void stage_rc(int b, int& R, int& C) { const int st = b / 1024, sb = b % 1024, swz = sb ^ (((sb >> 9) & 1) << 5); R = (st >> 1) * 16 + swz / 64; C = (st & 1) * 32 + (swz % 64) / 2; }
__host__ __device__ __forceinline__ int perm32(int rho) { const int n = rho >> 4, i = rho & 15; return 8 * (i >> 2) + 4 * n + (i & 3); }

struct Unit { int pm, pn, ko, nt, sp; };
struct Gemm { const bf16_t* A; const bf16_t* Bt; int M, N, K, ld; };

struct StaticOrder {
    int nM, nN, nwg, G, c, pm0, nsplit, klen, mode, pmx, xsplit;
    __host__ __device__ void init(int M, int N, int G_, int c_, int pm0_ = 0, int nsplit_ = 1, int klen_ = 0) { nM = M / BM; nN = N / BM; nwg = nM * nN; G = G_; c = c_; pm0 = pm0_; nsplit = nsplit_; klen = klen_; mode = 0; }
    __host__ __device__ bool next(int i, Unit& u) const {
        const long L = (long)i * G + c;
        if (mode == 3 && i >= 1) { if (i > 1 || c >= nN * xsplit) return false; u.pm = pmx; u.pn = c % nN; u.ko = (c / nN) * klen; u.nt = klen / BK; u.sp = 1; return true; }
        if (mode == 3) { if (L >= nwg) return false; }
        if (nsplit > 1) { if (L >= (long)nN * nsplit) return false; u.pm = pm0; u.pn = (int)(L % nN); u.ko = (int)(L / nN) * klen; u.nt = 0; u.sp = 1; return true; }
        if (mode == 2) { if (i > 0 || c < 0 || c >= 80) return false; if (c < 65) { u.pm = c; u.pn = 8; } else { u.pm = 50 + (c - 65); u.pn = 7; } u.ko = 0; u.nt = 0; u.sp = 0; return true; }
        if (mode == 1 && L >= nwg) { const long Lp = L - nwg; if (Lp >= 50) return false; u.pm = (int)Lp; u.pn = 7; u.ko = 0; u.nt = 0; u.sp = 0; return true; }
        if (L >= nwg) return false;
        int wgid = (int)L; { const int q = nwg / NXCD, r = nwg % NXCD, xcd = wgid % NXCD, off = wgid / NXCD; wgid = (xcd < r ? xcd * (q + 1) : r * (q + 1) + (xcd - r) * q) + off; }
        const int nig = WGM * nN, gid = wgid / nig, fm = gid * WGM, gsz = (nM - fm) < WGM ? (nM - fm) : WGM;
        u.pm = pm0 + fm + ((wgid % nig) % gsz); u.pn = (wgid % nig) / gsz; u.ko = 0; u.nt = 0; u.sp = 0; return true;
    }
    __device__ __forceinline__ void a_ready(const Unit&) const {}
    __device__ __forceinline__ void done(const Unit&) const {}
};

__device__ __forceinline__ unsigned cvt_pk_bf16(float lo, float hi) { unsigned r; asm volatile("v_cvt_pk_bf16_f32 %0, %1, %2" : "=v"(r) : "v"(lo), "v"(hi)); return r; }
typedef float f32x2 __attribute__((ext_vector_type(2)));
__device__ __forceinline__ float fast_sigmoid(float x) { return __builtin_amdgcn_rcpf(1.0f + __builtin_amdgcn_exp2f(-1.44269504089f * x)); }
struct EpiSwiGLU {
    static constexpr bool PERM = true, AFTER_DRAIN = false;
    bf16_t* O; int ldc;
    __device__ __forceinline__ void operator()(const f32x4 (&acc)[2][2][4][2], const Unit& u, int wr, int wc, int fr, int fq) const {
        const int row0 = u.pm * BM + wr * 64 + fr, col0 = u.pn * HALF + wc * 32 + 8 * fq;
#pragma unroll
        for (int ai = 0; ai < 2; ++ai)
#pragma unroll
            for (int m = 0; m < 4; ++m) {
                bf16_t* rowp = O + (size_t)(row0 + ai * HALF + m * 16) * ldc + col0;
                f32x4 g0, g1;
#pragma unroll
                for (int e = 0; e < 4; ++e) {
                    const float a0 = acc[ai][0][m][0][e], a1 = acc[ai][0][m][1][e];
                    g0[e] = a0 * fast_sigmoid(a0) * acc[ai][1][m][0][e];
                    g1[e] = a1 * fast_sigmoid(a1) * acc[ai][1][m][1][e];
                }
                u32x4 w; w.x = cvt_pk_bf16(g0[0], g0[1]); w.y = cvt_pk_bf16(g0[2], g0[3]); w.z = cvt_pk_bf16(g1[0], g1[1]); w.w = cvt_pk_bf16(g1[2], g1[3]);
                *(u32x4*)rowp = w;
            }
    }
};
struct EpiF32 {
    static constexpr bool PERM = true, AFTER_DRAIN = false;
    float* O; int ldc;
    __device__ __forceinline__ void operator()(const f32x4 (&acc)[2][2][4][2], const Unit& u, int wr, int wc, int fr, int fq) const {
        const int row0 = u.pm * BM + wr * 64 + fr, col0 = u.pn * BM + wc * 32 + 8 * fq;
#pragma unroll
        for (int ai = 0; ai < 2; ++ai)
#pragma unroll
            for (int m = 0; m < 4; ++m) {
                float* rowp = O + (size_t)(row0 + ai * HALF + m * 16) * ldc + col0;
#pragma unroll
                for (int bj = 0; bj < 2; ++bj) { *(f32x4*)(rowp + bj * HALF) = acc[ai][bj][m][0]; *(f32x4*)(rowp + bj * HALF + 4) = acc[ai][bj][m][1]; }
            }
    }
};
struct EpiB16 {
    static constexpr bool PERM = true, AFTER_DRAIN = false;
    bf16_t* O; int ldc;
    __device__ __forceinline__ void operator()(const f32x4 (&acc)[2][2][4][2], const Unit& u, int wr, int wc, int fr, int fq) const {
        const int row0 = u.pm * BM + wr * 64 + fr, col0 = u.pn * BM + wc * 32 + 8 * fq;
#pragma unroll
        for (int ai = 0; ai < 2; ++ai)
#pragma unroll
            for (int m = 0; m < 4; ++m) {
                bf16_t* rowp = O + (size_t)(row0 + ai * HALF + m * 16) * ldc + col0;
#pragma unroll
                for (int bj = 0; bj < 2; ++bj) { const f32x4 v0 = acc[ai][bj][m][0], v1 = acc[ai][bj][m][1];
                    u32x4 w; w.x = cvt_pk_bf16(v0[0], v0[1]); w.y = cvt_pk_bf16(v0[2], v0[3]); w.z = cvt_pk_bf16(v1[0], v1[1]); w.w = cvt_pk_bf16(v1[2], v1[3]);
                    *(u32x4*)(rowp + bj * HALF) = w; }
            }
    }
};

struct EpiMulti {
    static constexpr bool PERM = true, AFTER_DRAIN = false;
    int mode; void* O; int ldc; void* O2; int kshift;
    __device__ __forceinline__ void operator()(const f32x4 (&acc)[2][2][4][2], const Unit& u, int wr, int wc, int fr, int fq) const {
        if (u.sp && mode == 2) { Unit v = u; v.pm = u.ko >> kshift; EpiB16 e{(bf16_t*)O2, ldc}; e(acc, v, wr, wc, fr, fq); }
        else if (mode == 0) { EpiSwiGLU e{(bf16_t*)O, ldc}; e(acc, u, wr, wc, fr, fq); }
        else if (mode == 4) { Unit v = u; v.pm = u.ko >> 8; EpiB16 e{(bf16_t*)O, ldc}; e(acc, v, wr, wc, fr, fq); }
        else { EpiB16 e{(bf16_t*)O, ldc}; e(acc, u, wr, wc, fr, fq); }
    }
};
template <class Epi, class Sched, bool ALIGN_EPI = false, bool SP2 = false>
__device__ __forceinline__ void gemm_phase(PG8_LAS unsigned char* lds, const Gemm g, const Sched& S, const Epi& E) {
    const int tid = threadIdx.x, wid = __builtin_amdgcn_readfirstlane(tid >> 6), lane = tid & 63, wr = wid >> 2, wc = wid & 3, fr = lane & 15, fq = lane >> 4;
    const int K = g.ld; int nt = g.K / BK;
    unsigned voffA[2], voffB[2];
#pragma unroll
    for (int i = 0; i < 2; ++i) { int R, C; stage_rc(tid * 16 + i * 8192, R, C); const int Rb = Epi::PERM ? ((R & ~31) + perm32(R & 31)) : R;
        voffA[i] = (unsigned)(R * K + C) * 2u; voffB[i] = (unsigned)(Rb * K + C) * 2u; }
    const size_t kstep = (size_t)(BK * 2);
    const size_t hstep = (size_t)HALF * K * 2;
    const size_t tstep = 2 * hstep;
    const unsigned ldsw = (unsigned)wid * 1024u;
    const int aoff = lds_byte(wr * 64 + fr, fq * 8), boff = lds_byte(wc * 32 + fr, fq * 8);
#define PG8_SA(b, h) (((b) * 2 + (h)) * HTB)
#define PG8_SB(b, h) ((4 + (b) * 2 + (h)) * HTB)
#define PG8_STAGE(bufoff, gbase, voff) do { _Pragma("unroll") for (int _i = 0; _i < 2; ++_i) \
        __builtin_amdgcn_global_load_lds((const unsigned*)((const char*)(gbase) + (voff)[_i]), (PG8_LAS unsigned*)(lds + (bufoff) + ldsw + _i * 8192), 16, 0, 0); } while (0)
#define PG8_LDA(dst, b, h) do { _Pragma("unroll") for (int m = 0; m < 4; ++m) _Pragma("unroll") for (int k = 0; k < 2; ++k) dst[m][k] = *(const PG8_LAS bf16x8*)(lds + PG8_SA(b, h) + aoff + m * 2048 + k * 1024); } while (0)
#define PG8_LDB(dst, b, h) do { _Pragma("unroll") for (int n = 0; n < 2; ++n) _Pragma("unroll") for (int k = 0; k < 2; ++k) dst[n][k] = *(const PG8_LAS bf16x8*)(lds + PG8_SB(b, h) + boff + n * 2048 + k * 1024); } while (0)
#define PG8_MMA(ai, bj, At, Bt) do { __builtin_amdgcn_s_setprio(1); _Pragma("unroll") for (int m = 0; m < 4; ++m) _Pragma("unroll") for (int n = 0; n < 2; ++n) _Pragma("unroll") for (int k = 0; k < 2; ++k) \
        acc[ai][bj][m][n] = __builtin_amdgcn_mfma_f32_16x16x32_bf16(Bt[n][k], At[m][k], acc[ai][bj][m][n], 0, 0, 0); __builtin_amdgcn_s_setprio(0); } while (0)
#define PG8_WAIT_V(n) asm volatile("s_waitcnt vmcnt(" #n ")" ::: "memory")
#define PG8_WAIT_L(n) asm volatile("s_waitcnt lgkmcnt(" #n ")" ::: "memory")
#define PG8_BAR __builtin_amdgcn_s_barrier()
#define PG8_SCHED __builtin_amdgcn_sched_barrier(0)
    Unit cur, nxt; int ui = 0;
    if (!S.next(0, cur)) return;
    if (cur.nt > 0) nt = cur.nt;
    f32x4 acc[2][2][4][2];
#pragma unroll
    for (int a = 0; a < 2; ++a)
#pragma unroll
        for (int b = 0; b < 2; ++b)
#pragma unroll
            for (int m = 0; m < 4; ++m)
#pragma unroll
                for (int n = 0; n < 2; ++n) acc[a][b][m][n] = (f32x4){0.f, 0.f, 0.f, 0.f};
    bf16x8 At[4][2], B0[2][2], B1[2][2];
    const char* cA = (const char*)g.A + (size_t)cur.pm * tstep + (size_t)cur.ko * 2; const char* cB = (const char*)g.Bt + (size_t)cur.pn * tstep + (size_t)cur.ko * 2;
    S.a_ready(cur);
    if constexpr (SP2) {
        PG8_STAGE(PG8_SB(0, 0), cB, voffB); PG8_STAGE(PG8_SB(0, 1), cB + hstep, voffB); PG8_STAGE(PG8_SA(0, 0), cA, voffA); PG8_STAGE(PG8_SA(0, 1), cA + hstep, voffA);
        if (wr == 1) PG8_BAR;
        PG8_WAIT_V(2); PG8_BAR;
        PG8_STAGE(PG8_SB(1, 0), cB + kstep, voffB); PG8_STAGE(PG8_SA(1, 0), cA + kstep, voffA); PG8_STAGE(PG8_SB(1, 1), cB + hstep + kstep, voffB);
        PG8_WAIT_V(6); PG8_BAR;
    } else {
        PG8_STAGE(PG8_SB(0, 0), cB, voffB); PG8_STAGE(PG8_SA(0, 0), cA, voffA); PG8_STAGE(PG8_SB(0, 1), cB + hstep, voffB); PG8_STAGE(PG8_SA(0, 1), cA + hstep, voffA);
        if (wr == 1) PG8_BAR;
        PG8_WAIT_V(4); PG8_BAR;
        PG8_STAGE(PG8_SB(1, 0), cB + kstep, voffB); PG8_STAGE(PG8_SA(1, 0), cA + kstep, voffA); PG8_STAGE(PG8_SB(1, 1), cB + hstep + kstep, voffB);
        PG8_WAIT_V(6); PG8_BAR;
    }
    for (;;) {
        const bool has_next = S.next(ui + 1, nxt);
        const char* nA = has_next ? (const char*)g.A + (size_t)nxt.pm * tstep + (size_t)nxt.ko * 2 : cA; const char* nB = has_next ? (const char*)g.Bt + (size_t)nxt.pn * tstep + (size_t)nxt.ko * 2 : cB;
        for (int t = 0; t < nt; t += 2) {
            const bool last = (t == nt - 2);
            const char* a1 = cA + (size_t)(t + 1) * kstep;
            const char* a2 = last ? nA : cA + (size_t)(t + 2) * kstep; const char* b2 = last ? nB : cB + (size_t)(t + 2) * kstep;
            const char* a3 = a2 + kstep; const char* b3 = b2 + kstep;
            if (last && has_next) S.a_ready(nxt);
            if constexpr (SP2) {
            PG8_LDB(B0, 0, 0); PG8_LDB(B1, 0, 1); PG8_SCHED; PG8_LDA(At, 0, 0); PG8_STAGE(PG8_SA(1, 1), a1 + hstep, voffA);
            PG8_WAIT_V(8); PG8_WAIT_L(0); PG8_BAR; PG8_MMA(0, 0, At, B0); PG8_MMA(0, 1, At, B1); PG8_BAR; PG8_SCHED;
            PG8_LDA(At, 0, 1); PG8_STAGE(PG8_SB(0, 0), b2, voffB); PG8_STAGE(PG8_SB(0, 1), b2 + hstep, voffB); PG8_STAGE(PG8_SA(0, 0), a2, voffA);
            PG8_WAIT_V(8); PG8_WAIT_L(0); PG8_BAR; PG8_MMA(1, 0, At, B0); PG8_MMA(1, 1, At, B1); PG8_BAR; PG8_SCHED;
            PG8_LDB(B0, 1, 0); PG8_LDB(B1, 1, 1); PG8_SCHED; PG8_LDA(At, 1, 0); PG8_STAGE(PG8_SA(0, 1), a2 + hstep, voffA);
            PG8_WAIT_V(8); PG8_WAIT_L(0); PG8_BAR; PG8_MMA(0, 0, At, B0); PG8_MMA(0, 1, At, B1); PG8_BAR; PG8_SCHED;
            PG8_LDA(At, 1, 1); PG8_STAGE(PG8_SB(1, 0), b3, voffB); PG8_STAGE(PG8_SB(1, 1), b3 + hstep, voffB); PG8_STAGE(PG8_SA(1, 0), a3, voffA);
            PG8_WAIT_V(8); PG8_WAIT_L(0); PG8_BAR; PG8_MMA(1, 0, At, B0); PG8_MMA(1, 1, At, B1); PG8_BAR; PG8_SCHED;
            } else {
            PG8_LDB(B0, 0, 0); PG8_SCHED; PG8_LDA(At, 0, 0); PG8_STAGE(PG8_SA(1, 1), a1 + hstep, voffA);
            PG8_WAIT_L(8); PG8_BAR; PG8_WAIT_L(0); PG8_MMA(0, 0, At, B0); PG8_BAR; PG8_SCHED;
            PG8_LDB(B1, 0, 1); PG8_STAGE(PG8_SB(0, 0), b2, voffB);
            PG8_BAR; PG8_WAIT_L(0); PG8_MMA(0, 1, At, B1); PG8_BAR;
            PG8_LDA(At, 0, 1); PG8_STAGE(PG8_SA(0, 0), a2, voffA);
            PG8_BAR; PG8_WAIT_L(0); PG8_MMA(1, 0, At, B0); PG8_BAR; PG8_SCHED;
            PG8_STAGE(PG8_SB(0, 1), b2 + hstep, voffB);
            PG8_WAIT_V(6); PG8_BAR; PG8_MMA(1, 1, At, B1); PG8_BAR;
            PG8_LDB(B0, 1, 0); PG8_SCHED; PG8_LDA(At, 1, 0); PG8_STAGE(PG8_SA(0, 1), a2 + hstep, voffA);
            PG8_WAIT_L(8); PG8_BAR; PG8_WAIT_L(0); PG8_MMA(0, 0, At, B0); PG8_BAR; PG8_SCHED;
            PG8_LDB(B1, 1, 1); PG8_STAGE(PG8_SB(1, 0), b3, voffB);
            PG8_BAR; PG8_WAIT_L(0); PG8_MMA(0, 1, At, B1); PG8_BAR;
            PG8_LDA(At, 1, 1); PG8_STAGE(PG8_SA(1, 0), a3, voffA);
            PG8_BAR; PG8_WAIT_L(0); PG8_MMA(1, 0, At, B0); PG8_BAR; PG8_SCHED;
            PG8_STAGE(PG8_SB(1, 1), b3 + hstep, voffB);
            PG8_WAIT_V(6); PG8_BAR; PG8_MMA(1, 1, At, B1); PG8_BAR;
            }
        }
        if constexpr (ALIGN_EPI) { if (wr == 0) PG8_BAR; }
        if constexpr (!Epi::AFTER_DRAIN) { E(acc, cur, wr, wc, fr, fq); S.done(cur); }
        if (!has_next) break;
#pragma unroll
        for (int a = 0; a < 2; ++a)
#pragma unroll
            for (int b = 0; b < 2; ++b)
#pragma unroll
                for (int m = 0; m < 4; ++m)
#pragma unroll
                    for (int n = 0; n < 2; ++n) acc[a][b][m][n] = (f32x4){0.f, 0.f, 0.f, 0.f};
        cur = nxt; cA = nA; cB = nB; ++ui; if (cur.nt > 0) nt = cur.nt;
        if constexpr (ALIGN_EPI) { if (wr == 1) PG8_BAR; }
    }
    PG8_WAIT_V(0);
    if constexpr (!ALIGN_EPI) { if (wr == 0) PG8_BAR; }
    PG8_BAR;
    if constexpr (Epi::AFTER_DRAIN) { E.fused(acc, cur, wr, wc, fr, fq, lds, wid, lane); S.done(cur); }
#undef PG8_SA
#undef PG8_SB
#undef PG8_STAGE
#undef PG8_LDA
#undef PG8_LDB
#undef PG8_MMA
#undef PG8_WAIT_V
#undef PG8_WAIT_L
#undef PG8_BAR
#undef PG8_SCHED
}
}

#ifndef MK_NO_PRO
#define MK_NO_PRO 0
#endif
#ifndef MK_NO_MIX1
#define MK_NO_MIX1 0
#endif
#ifndef MK_NO_MIX2
#define MK_NO_MIX2 0
#endif
#ifndef MK_NO_G1
#define MK_NO_G1 0
#endif
#ifndef MK_NO_G2
#define MK_NO_G2 0
#endif
#ifndef MK_NO_G3
#define MK_NO_G3 0
#endif
#ifndef MK_CHECK
#define MK_CHECK 0
#endif
#ifndef MK_PROBE
#define MK_PROBE 0
#endif
#ifndef MK_DEFER_WIN
#define MK_DEFER_WIN 1
#endif
#ifndef MK_STREAM_TAIL
#define MK_STREAM_TAIL 1
#endif
#ifndef MK_ONE_LAUNCH
#define MK_ONE_LAUNCH 1
#endif
namespace mk {
#define LAS __attribute__((address_space(3)))
typedef unsigned short bf16_t;
typedef float f32x4 __attribute__((ext_vector_type(4)));
typedef unsigned u32x4 __attribute__((ext_vector_type(4)));
typedef unsigned u32x2 __attribute__((ext_vector_type(2)));
constexpr int NWAVES = 8, NTHR = 512;
constexpr int D = 1024, TP = 16384, NSB = 8, TSS = 16, MV = 16512, MP = 16640, DFF = 2816, DIN = 2304, NL = 4;
constexpr int DA = 256, DB = 512, DC = 256;
constexpr int COL_AB = 0, COL_AC = 256, COL_AX = 512, COL_BX = 768, COL_BG = 1280, COL_CV = 1792, COL_CG = 2048;
constexpr float EPS = 1e-6f;
constexpr int LDS_BYTES = 147456;
constexpr size_t MiB = 1u << 20;
constexpr size_t WS_W13 = 1 * MiB, WS_W2 = 89 * MiB, WS_WIN = 133 * MiB, WS_WOUT = 151 * MiB, WS_MOD = 159 * MiB, WS_AGG = 161 * MiB,
                 WS_X = 163 * MiB, WS_F = 228 * MiB, WS_H = 293 * MiB, WS_Y = 326 * MiB, WS_HL = 359 * MiB, WS_AC = 392 * MiB, WS_GU = 425 * MiB, WS_FPART = 515 * MiB, WS_END = 527 * MiB;
constexpr size_t W13_BYTES = (size_t)2 * DFF * D * 2, W2_BYTES = (size_t)D * DFF * 2, WIN_BYTES = (size_t)DIN * D * 2, WOUT_BYTES = (size_t)D * D * 2;
constexpr size_t O_Y = 0, O_CAP = 16908288, O_CBP = 16910336, O_HP = 16916480, O_CCP = 16918528, O_CAS = 16949248, O_CBS = 16965632, O_HS = 17014784, O_CCS = 17031168, O_END = 17276928;
constexpr int NPH = 2 + 11 * NL;
constexpr int NSTEP = MK_PROBE == 4 ? NPH + 1 : (MK_PROBE == 2 || MK_PROBE == 3) ? 2 + 12 * NL : (MK_PROBE == 5 || MK_PROBE == 6) ? 2 + 14 * NL : NPH;
constexpr int NCHUNK = 256 + NSB;

struct Args { const float* in[30]; float* out; unsigned char* ws; int ph_lo, ph_hi; };
typedef const __attribute__((address_space(4))) Args* CArgs;
enum { I_XP = 0, I_XS, I_SA, I_SB, I_SH, I_SC, I_CP, I_CS, I_WADA, I_BADA, I_NPRE, I_NPOST, I_W1, I_W3, I_W2, I_WIN, I_WOUT, I_WCA, I_WCB, I_BCB,
       I_WGR, I_BGR, I_WGI, I_BGI, I_LAM, I_WCC, I_BCC, I_LNG, I_LNB, I_GRP };

__device__ __forceinline__ float wave_sum_l(float v, int lane) {
#pragma unroll
    for (int o = 1; o < 64; o <<= 1) v += __builtin_bit_cast(float, __builtin_amdgcn_ds_bpermute((lane ^ o) << 2, __builtin_bit_cast(int, v)));
    return v;
}
#define wave_sum(v) wave_sum_l((v), lane)
#define LDS_BARRIER() do { asm volatile("s_waitcnt lgkmcnt(0)" ::: "memory"); __builtin_amdgcn_s_barrier(); asm volatile("" ::: "memory"); } while (0)
__device__ __forceinline__ void wave_sum4_l(float& a, float& b, float& c, float& d, int lane) {
#pragma unroll
    for (int o = 1; o < 64; o <<= 1) { const int idx = (lane ^ o) << 2;
        const float a2 = __builtin_bit_cast(float, __builtin_amdgcn_ds_bpermute(idx, __builtin_bit_cast(int, a))), b2 = __builtin_bit_cast(float, __builtin_amdgcn_ds_bpermute(idx, __builtin_bit_cast(int, b)));
        const float c2 = __builtin_bit_cast(float, __builtin_amdgcn_ds_bpermute(idx, __builtin_bit_cast(int, c))), d2 = __builtin_bit_cast(float, __builtin_amdgcn_ds_bpermute(idx, __builtin_bit_cast(int, d)));
        a += a2; b += b2; c += c2; d += d2; }
}
__device__ __forceinline__ unsigned f2bf(float f) { unsigned u = __builtin_bit_cast(unsigned, f); return (u + 0x7fffu + ((u >> 16) & 1u)) >> 16; }
__device__ __forceinline__ unsigned pk2(float lo, float hi) { unsigned r; asm("v_cvt_pk_bf16_f32 %0, %1, %2" : "=v"(r) : "v"(lo), "v"(hi)); return r; }
__device__ __forceinline__ float bflo(unsigned u) { return __builtin_bit_cast(float, u << 16); }
__device__ __forceinline__ float bfhi(unsigned u) { return __builtin_bit_cast(float, u & 0xffff0000u); }
__device__ __forceinline__ f32x4 ld_bf4(const bf16_t* p) { const u32x2 v = *(const u32x2*)p; return (f32x4){bflo(v.x), bfhi(v.x), bflo(v.y), bfhi(v.y)}; }
__device__ __forceinline__ float bf1(const bf16_t* p) { return __builtin_bit_cast(float, (unsigned)(*p) << 16); }
__device__ __forceinline__ float sigm(float x) { return __builtin_amdgcn_rcpf(1.0f + __builtin_amdgcn_exp2f(-1.44269504089f * x)); }
__device__ __forceinline__ float gelu_tanh(float x) { return x * sigm(1.5957691216f * (x + 0.044715f * x * x * x)); }
__device__ __forceinline__ float hsum4(f32x4 v) { return (v[0] + v[1]) + (v[2] + v[3]); }
__device__ __forceinline__ float hsq4(f32x4 v) { return (v[0] * v[0] + v[1] * v[1]) + (v[2] * v[2] + v[3] * v[3]); }

__device__ __forceinline__ void transpose_item(const float* W, int K, int N, bf16_t* WT, LAS float* scr, int kb, int nb, int dst_row0, int lane) {
    const int k0 = 64 * kb, n0 = 32 * nb;
#pragma unroll 8
    for (int i = 0; i < 32; ++i) { const int kk = 2 * i + (lane >> 5); scr[kk * 33 + (lane & 31)] = W[(size_t)(k0 + kk) * N + n0 + (lane & 31)]; }
    asm volatile("s_waitcnt lgkmcnt(0)" ::: "memory");
    const int c = lane & 7;
#pragma unroll
    for (int j = 0; j < 4; ++j) { const int n = (lane >> 3) + 8 * j; const LAS float* s = scr + (8 * c) * 33 + n;
        u32x4 o; o.x = pk2(s[0 * 33], s[1 * 33]); o.y = pk2(s[2 * 33], s[3 * 33]); o.z = pk2(s[4 * 33], s[5 * 33]); o.w = pk2(s[6 * 33], s[7 * 33]);
        *(u32x4*)(WT + (size_t)(dst_row0 + n) * K + k0 + 8 * c) = o; }
    asm volatile("s_waitcnt lgkmcnt(0)" ::: "memory");
}

__device__ __forceinline__ void phase_prologue(CArgs a, LAS unsigned char* lds, int tid, int lane, int wave) {
    unsigned char* ws = a->ws;
    {
        LAS float* sc = (LAS float*)lds;
        LAS float* red = sc + 9 * 1024;
        for (int e = tid; e < 9 * 1024; e += NTHR) { const int b = e >> 10, k = e & 1023; const float c = b == 0 ? a->in[I_CP][k] : a->in[I_CS][(b - 1) * 1024 + k]; sc[e] = c * sigm(c); }
        __syncthreads();
        float* mod = (float*)(ws + WS_MOD);
        const int kk = tid >> 5, cl = tid & 31;
        for (int u = blockIdx.x; u < NL * 72; u += gridDim.x) {
            const int l = u / 72, n0 = 128 * (u % 72);
            f32x4 acc[9];
#pragma unroll
            for (int b = 0; b < 9; ++b) acc[b] = (f32x4){0.f, 0.f, 0.f, 0.f};
            const float* wp = a->in[I_WADA] + (size_t)l * 1024 * 9216 + n0 + 4 * cl;
#pragma unroll 4
            for (int k = kk; k < 1024; k += 16) {
                const f32x4 w = *(const f32x4*)(wp + (size_t)k * 9216);
#pragma unroll
                for (int b = 0; b < 9; ++b) acc[b] += sc[b * 1024 + k] * w;
            }
#pragma unroll
            for (int b = 0; b < 9; ++b)
#pragma unroll
                for (int e = 0; e < 4; ++e) { const float av = acc[b][e]; acc[b][e] = av + __builtin_bit_cast(float, __builtin_amdgcn_ds_bpermute((lane ^ 32) << 2, __builtin_bit_cast(int, av))); }
            if (lane < 32) {
#pragma unroll
                for (int b = 0; b < 9; ++b) *(LAS f32x4*)(red + (wave * 9 + b) * 128 + 4 * cl) = acc[b];
            }
            __syncthreads();
            for (int o = tid; o < 9 * 128; o += NTHR) {
                const int b = o >> 7, c = o & 127; float s = 0.f;
#pragma unroll
                for (int w = 0; w < 8; ++w) s += red[(w * 9 + b) * 128 + c];
                mod[((size_t)l * 9 + b) * 9216 + n0 + c] = s + a->in[I_BADA][l * 9216 + n0 + c];
            }
            __syncthreads();
        }
    }
    __syncthreads();
    {
        LAS float* scr = (LAS float*)(lds + wave * 8448);
        const int gw = blockIdx.x * NWAVES + wave, NGW = gridDim.x * NWAVES;
        constexpr int I13 = 16 * 88, I2 = 44 * 32, IIN = 16 * 72, IOUT = 16 * 32;
        constexpr int PER_L = 4 * I13 + 2 * I2 + IIN + IOUT;
        for (int it = gw; it < NL * PER_L; it += NGW) {
            const int l = it / PER_L; int r = it % PER_L;
            if (r < 4 * I13) {
                const int which = r / (2 * I13); r %= 2 * I13; const int s = r / I13, q = r % I13, kb = q / 88, nb = q % 88;
                const float* W = a->in[which ? I_W3 : I_W1] + (size_t)(l * 2 + s) * D * DFF;
                bf16_t* WT = (bf16_t*)(ws + WS_W13 + (size_t)(l * 2 + s) * W13_BYTES);
                const int n0 = 32 * nb, dst = (n0 >> 7) * 256 + (n0 & 127) + (which ? 128 : 0);
                transpose_item(W, D, DFF, WT, scr, kb, nb, dst, lane);
                continue;
            }
            r -= 4 * I13;
            if (r < 2 * I2) {
                const int s = r / I2, q = r % I2, kb = q / 32, nb = q % 32;
                transpose_item(a->in[I_W2] + (size_t)(l * 2 + s) * DFF * D, DFF, D, (bf16_t*)(ws + WS_W2 + (size_t)(l * 2 + s) * W2_BYTES), scr, kb, nb, 32 * nb, lane);
                continue;
            }
            r -= 2 * I2;
            if (r < IIN) { const int kb = r / 72, nb = r % 72;
                transpose_item(a->in[I_WIN] + (size_t)l * D * DIN, D, DIN, (bf16_t*)(ws + WS_WIN + (size_t)l * WIN_BYTES), scr, kb, nb, 32 * nb, lane); continue; }
            r -= IIN;
            { const int kb = r / 32, nb = r % 32;
                transpose_item(a->in[I_WOUT] + (size_t)l * D * D, D, D, (bf16_t*)(ws + WS_WOUT + (size_t)l * WOUT_BYTES), scr, kb, nb, 32 * nb, lane); }
        }
    }
}

__device__ __forceinline__ void phase_rows(CArgs a, int lane, int wave, int mode, bool final_, float coef, int nsplit,
                                           const float* modc, int gidx, const float* gpost, const float* modn, int scidx, int shidx, const float* gpre) {
    unsigned char* ws = a->ws;
    bf16_t* X = (bf16_t*)(ws + WS_X); const bf16_t* Fb = (const bf16_t*)(ws + WS_F); bf16_t* H = (bf16_t*)(ws + WS_H);
    const int gw = blockIdx.x * NWAVES + wave, NGW = gridDim.x * NWAVES;
    {
        f32x4 gg[4], gs[4], tt[4];
#pragma unroll
        for (int j = 0; j < 4; ++j) { const int c = 4 * lane + 256 * j;
            gg[j] = mode ? coef * *(const f32x4*)(modc + (size_t)gidx * D + c) * *(const f32x4*)(gpost + c) : (f32x4){0.f, 0.f, 0.f, 0.f};
            gs[j] = *(const f32x4*)(gpre + c) * (1.0f + *(const f32x4*)(modn + (size_t)scidx * D + c));
            tt[j] = *(const f32x4*)(modn + (size_t)shidx * D + c); }
        const float* xin = a->in[I_XP];
        constexpr int LA = 3;
        u32x2 xq[LA + 1][4], fq[LA + 1][4]; f32x4 xf[LA + 1][4];
#define ROWS_LOAD(S_, R_) do { if ((R_) < TP) { _Pragma("unroll") for (int j = 0; j < 4; ++j) { const size_t o_ = (size_t)(R_) * D + 4 * lane + 256 * j; \
            if (mode) { xq[S_][j] = *(const u32x2*)(X + o_); fq[S_][j] = *(const u32x2*)(Fb + o_); } else xf[S_][j] = *(const f32x4*)(xin + o_); } } } while (0)
        int r = gw;
        ROWS_LOAD(0, r); ROWS_LOAD(1, r + NGW); ROWS_LOAD(2, r + 2 * NGW);
        while (r < TP) {
            ROWS_LOAD(3, r + 3 * NGW);
            f32x4 x[4];
            if (mode) {
                f32x4 f[4]; float ss = 0.f;
#pragma unroll
                for (int j = 0; j < 4; ++j) { f[j] = (f32x4){bflo(fq[0][j].x), bfhi(fq[0][j].x), bflo(fq[0][j].y), bfhi(fq[0][j].y)}; ss += hsq4(f[j]); }
                const float rstd = __builtin_amdgcn_rsqf(wave_sum(ss) * (1.0f / D) + EPS);
#pragma unroll
                for (int j = 0; j < 4; ++j) x[j] = (f32x4){bflo(xq[0][j].x), bfhi(xq[0][j].x), bflo(xq[0][j].y), bfhi(xq[0][j].y)} + gg[j] * (f[j] * rstd);
            } else {
#pragma unroll
                for (int j = 0; j < 4; ++j) x[j] = xf[0][j];
            }
            if (final_) {
#pragma unroll
                for (int j = 0; j < 4; ++j) *(f32x4*)(a->out + (size_t)r * D + 4 * lane + 256 * j) = x[j];
            } else {
                float ss = 0.f;
#pragma unroll
                for (int j = 0; j < 4; ++j) { u32x2 xo; xo.x = pk2(x[j][0], x[j][1]); xo.y = pk2(x[j][2], x[j][3]); *(u32x2*)(X + (size_t)r * D + 4 * lane + 256 * j) = xo;
                    x[j] = (f32x4){bflo(xo.x), bfhi(xo.x), bflo(xo.y), bfhi(xo.y)}; ss += hsq4(x[j]); }
                const float rstd = __builtin_amdgcn_rsqf(wave_sum(ss) * (1.0f / D) + EPS);
#pragma unroll
                for (int j = 0; j < 4; ++j) { const f32x4 h = (x[j] * rstd) * gs[j] + tt[j];
                    u32x2 o; o.x = pk2(h[0], h[1]); o.y = pk2(h[2], h[3]);
                    *(u32x2*)(H + (size_t)r * D + 4 * lane + 256 * j) = o; }
            }
#pragma unroll
            for (int s = 0; s < LA; ++s)
#pragma unroll
                for (int j = 0; j < 4; ++j) { xq[s][j] = xq[s + 1][j]; fq[s][j] = fq[s + 1][j]; xf[s][j] = xf[s + 1][j]; }
            r += NGW;
        }
#undef ROWS_LOAD
    }
    for (int r = TP + gw; r < MV; r += NGW) {
        const int bidx = 1 + ((r - TP) >> 4);
        f32x4 x[4];
        if (mode == 0) {
            const float* src = a->in[I_XS] + (size_t)(r - TP) * D;
#pragma unroll
            for (int j = 0; j < 4; ++j) x[j] = *(const f32x4*)(src + 4 * lane + 256 * j);
        } else {
            f32x4 f[4]; float ss = 0.f;
#pragma unroll
            for (int j = 0; j < 4; ++j) {
                u32x2 pr[22];
#pragma unroll
                for (int s = 0; s < 22; ++s) pr[s] = s < nsplit ? *(const u32x2*)((const bf16_t*)(ws + WS_FPART) + ((size_t)s * 256 + (r - TP)) * D + 4 * lane + 256 * j) : (u32x2){0u, 0u};
                f[j] = (f32x4){0.f, 0.f, 0.f, 0.f};
#pragma unroll
                for (int s = 0; s < 22; ++s) f[j] += (f32x4){bflo(pr[s].x), bfhi(pr[s].x), bflo(pr[s].y), bfhi(pr[s].y)};
                ss += hsq4(f[j]); }
#pragma unroll
            for (int j = 0; j < 4; ++j) x[j] = ld_bf4(X + (size_t)r * D + 4 * lane + 256 * j);
            const float rstd = coef * __builtin_amdgcn_rsqf(wave_sum(ss) * (1.0f / D) + EPS);
            const float* gate = modc + ((size_t)bidx * 9 + gidx) * D;
#pragma unroll
            for (int j = 0; j < 4; ++j) { const f32x4 g = *(const f32x4*)(gate + 4 * lane + 256 * j), gp = *(const f32x4*)(gpost + 4 * lane + 256 * j);
                x[j] += g * (f[j] * rstd * gp); }
        }
        if (final_) {
#pragma unroll
            for (int j = 0; j < 4; ++j) *(f32x4*)(a->out + (size_t)r * D + 4 * lane + 256 * j) = x[j];
        } else {
            float ss = 0.f;
#pragma unroll
            for (int j = 0; j < 4; ++j) { u32x2 xo; xo.x = pk2(x[j][0], x[j][1]); xo.y = pk2(x[j][2], x[j][3]); *(u32x2*)(X + (size_t)r * D + 4 * lane + 256 * j) = xo;
                x[j] = (f32x4){bflo(xo.x), bfhi(xo.x), bflo(xo.y), bfhi(xo.y)}; ss += hsq4(x[j]); }
            const float rstd = __builtin_amdgcn_rsqf(wave_sum(ss) * (1.0f / D) + EPS);
            const float* sc = modn + ((size_t)bidx * 9 + scidx) * D; const float* sh = modn + ((size_t)bidx * 9 + shidx) * D;
#pragma unroll
            for (int j = 0; j < 4; ++j) { const int c = 4 * lane + 256 * j;
                const f32x4 g = *(const f32x4*)(gpre + c), s = *(const f32x4*)(sc + c), t = *(const f32x4*)(sh + c);
                const f32x4 h = (x[j] * rstd * g) * (1.0f + s) + t;
                u32x2 o; o.x = pk2(h[0], h[1]); o.y = pk2(h[2], h[3]);
                *(u32x2*)(H + (size_t)r * D + c) = o; }
        }
    }
}

typedef short bf16x8v __attribute__((ext_vector_type(8)));
typedef float f32x16 __attribute__((ext_vector_type(16)));
__device__ __forceinline__ void phase_mix1(CArgs a, LAS unsigned char* lds, int l, int tid, int lane, int wave, bool defer_win) {
    unsigned char* ws = a->ws;
    const bf16_t* U = (const bf16_t*)(ws + WS_GU);
    float* AGG = (float*)(ws + WS_AGG);
    LAS bf16_t* XB = (LAS bf16_t*)lds;
    LAS bf16_t* WT = XB + 64 * 72;
    LAS float* PRE = (LAS float*)(WT + 2 * 64 * 72);
    LAS float* comb = PRE + 2 * 64 * 64;
    const int j = lane, tg = wave;
    const int mg = wave & 1, mtb = (wave >> 1) & 1, mjb = wave >> 2, mr = lane & 31, mh = lane >> 5;
    float wcb[4];
    float br = 0.f, bi = 0.f, lsig = 0.f, bcb = 0.f;
    int cur_head = -1;
    unsigned* HLAC = (unsigned*)(ws + WS_HL);
    float bx[11];
    unsigned short rawu[11]; float raws[11];
#define MIX1_ISSUE(W_) do { const int head_ = (W_) & 7, chunk_ = (W_) >> 3, chg_ = 64 * head_ + j; const bool smp_ = chunk_ >= 256; \
        const int sb_ = smp_ ? chunk_ - 256 : 0, row0_ = smp_ ? TP + TSS * sb_ : 64 * chunk_; \
        const float* sbp_ = a->in[I_SB] + (size_t)(l * NSB + sb_) * 3 * DB + chg_; \
        _Pragma("unroll") for (int q = 0; q < 11; ++q) { const int t_ = tg * 8 - 3 + q; int ru_ = row0_ + t_; \
            ru_ = ru_ < 0 ? 0 : (ru_ > MV - 1 ? MV - 1 : ru_); int si_ = 3 + t_; si_ = si_ < 0 ? 0 : (si_ > 2 ? 2 : si_); \
            rawu[q] = U[(size_t)ru_ * DIN + COL_BX + chg_]; raws[q] = sbp_[(size_t)si_ * DB]; } \
        __builtin_amdgcn_sched_barrier(0); } while (0)
#define MIX1_CONSUME(W_) do { const int chunk_ = (W_) >> 3; const bool smp_ = chunk_ >= 256; \
        const int row0_ = smp_ ? TP + TSS * (chunk_ - 256) : 64 * chunk_, len_ = smp_ ? TSS : 64; \
        _Pragma("unroll") for (int q = 0; q < 11; ++q) { const int t_ = tg * 8 - 3 + q; const int ru_ = row0_ + t_; \
            const bool uok_ = (t_ < len_) && (ru_ >= 0) && (t_ >= 0 || !smp_), sok_ = smp_ && t_ < 0; \
            bx[q] = __builtin_bit_cast(float, (unsigned)rawu[q] << 16) * (uok_ ? 1.0f : 0.0f) + raws[q] * (sok_ ? 1.0f : 0.0f); } } while (0)
    int w0 = (int)blockIdx.x, wstep = (int)gridDim.x, wend = 8 * NCHUNK;
    if (defer_win) { const int hd = (int)blockIdx.x & 7, rk = (int)blockIdx.x >> 3;
        if (rk < 22) { w0 = rk * 8 + hd; wstep = 22 * 8; wend = 214 * 8; } else { w0 = (214 + rk - 22) * 8 + hd; wstep = 10 * 8; wend = 8 * NCHUNK; } }
    if (w0 < wend) MIX1_ISSUE(w0);
    for (int w = w0; w < wend; w += wstep) {
        const int head = w & 7, chunk = w >> 3, chg = 64 * head + j;
        if (head != cur_head) {
            cur_head = head;
            LDS_BARRIER();
            const float* pr = a->in[I_WGR] + (size_t)(l * 8 + head) * 4096; const float* pi = a->in[I_WGI] + (size_t)(l * 8 + head) * 4096;
            for (int e = tid; e < 4096; e += NTHR) { const int k = e >> 6, jj = e & 63; WT[jj * 72 + k] = (bf16_t)f2bf(pr[e]); WT[64 * 72 + jj * 72 + k] = (bf16_t)f2bf(pi[e]); }
            br = a->in[I_BGR][l * DB + chg]; bi = a->in[I_BGI][l * DB + chg];
            const float lam = a->in[I_LAM][l * DB + chg]; lsig = -log1pf(expf(-lam));
#pragma unroll
            for (int k = 0; k < 4; ++k) wcb[k] = a->in[I_WCB][(l * 4 + k) * DB + chg];
            bcb = a->in[I_BCB][l * DB + chg];
        }
        int row0, len;
        if (chunk < 256) { row0 = 64 * chunk; len = 64; } else { row0 = TP + TSS * (chunk - 256); len = TSS; }
        MIX1_CONSUME(w);
        float xb[8];
#pragma unroll
        for (int i = 0; i < 8; ++i) { xb[i] = bcb + wcb[0] * bx[i] + wcb[1] * bx[i + 1] + wcb[2] * bx[i + 2] + wcb[3] * bx[i + 3]; XB[(tg * 8 + i) * 72 + j] = (bf16_t)f2bf(xb[i]); }
        LDS_BARRIER();
        if (w + wstep < wend) MIX1_ISSUE(w + wstep);
        {
            f32x16 acc;
#pragma unroll
            for (int i = 0; i < 16; ++i) acc[i] = 0.f;
#pragma unroll
            for (int ks = 0; ks < 4; ++ks) {
                const bf16x8v av = *(const LAS bf16x8v*)(XB + (mtb * 32 + mr) * 72 + ks * 16 + 8 * mh);
                const bf16x8v bv = *(const LAS bf16x8v*)(WT + mg * 64 * 72 + (mjb * 32 + mr) * 72 + ks * 16 + 8 * mh);
                acc = __builtin_amdgcn_mfma_f32_32x32x16_bf16(av, bv, acc, 0, 0, 0);
            }
#pragma unroll
            for (int i = 0; i < 16; ++i) PRE[(mg * 64 + mtb * 32 + (i & 3) + 8 * (i >> 2) + 4 * mh) * 64 + mjb * 32 + mr] = acc[i];
        }
        LDS_BARRIER();
        float hl[8], ac[8]; float Ac = 1.f, hc = 0.f;
#pragma unroll
        for (int t = 0; t < 8; ++t) {
            if (tg * 8 + t < len) {
                const float r = sigm(br + PRE[(tg * 8 + t) * 64 + j]), ig = sigm(bi + PRE[(64 + tg * 8 + t) * 64 + j]);
                const float la = 8.0f * r * lsig, av = __expf(la);
                const float bt = __builtin_amdgcn_sqrtf(fmaxf(1.0f - av * av, 0.f)) * ig * xb[t];
                hc = av * hc + bt; Ac *= av;
            }
            hl[t] = hc; ac[t] = Ac;
        }
        comb[(tg * 2 + 0) * 64 + j] = Ac; comb[(tg * 2 + 1) * 64 + j] = hc;
        LDS_BARRIER();
        float Ap = 1.f, Hp = 0.f;
        for (int g = 0; g < tg; ++g) { const float Ag = comb[(g * 2) * 64 + j], Hg = comb[(g * 2 + 1) * 64 + j]; Hp = Ag * Hp + Hg; Ap *= Ag; }
#pragma unroll
        for (int t = 0; t < 8; ++t) {
            if (tg * 8 + t < len) HLAC[(size_t)(row0 + tg * 8 + t) * DB + chg] = pk2(hl[t] + ac[t] * Hp, ac[t] * Ap);
        }
        if (tg == 7) { AGG[((size_t)chunk * 2 + 0) * DB + chg] = ac[7] * Ap; AGG[((size_t)chunk * 2 + 1) * DB + chg] = hl[7] + ac[7] * Hp; }
        LDS_BARRIER();
    }
#undef MIX1_ISSUE
#undef MIX1_CONSUME
}

__device__ __forceinline__ void phase_mix2(CArgs a, LAS unsigned char* lds, int l, int tid, int lane, int wave) {
    unsigned char* ws = a->ws;
    const bf16_t* U = (const bf16_t*)(ws + WS_GU); bf16_t* Y = (bf16_t*)(ws + WS_Y);
    const unsigned* HLAC = (const unsigned*)(ws + WS_HL); const float* AGG = (const float*)(ws + WS_AGG);
    LAS float* vs = (LAS float*)lds;
    LAS float* carry = vs + 62 * 256;
    const int c4 = 4 * lane, c8 = 8 * lane;
    LAS float* wcs = carry + 512;
    for (int e = tid; e < 31 * 64; e += NTHR) *(LAS f32x4*)(wcs + 4 * e) = *(const f32x4*)(a->in[I_WCC] + (size_t)l * 31 * DC + 4 * e);
    const float* bccp = a->in[I_BCC] + l * DC + c4; const float* lngp = a->in[I_LNG] + l * DC + c4; const float* lnbp = a->in[I_LNB] + l * DC + c4;
    const float* grp = a->in[I_GRP] + l * D;
    const float* wap = a->in[I_WCA] + (size_t)l * 3 * DA + c4;
    for (int unit = blockIdx.x; unit < 256 + NSB; unit += gridDim.x)
    for (int half = 0; half < (unit < 256 ? 2 : 1); ++half) {
        int row0, len, t0, sb = -1; bool islast;
        if (unit >= 256) { sb = unit - 256; row0 = TP + TSS * sb; len = TSS; t0 = 0; islast = true; }
        else { const int pi = 2 * unit + half; row0 = 32 * pi; len = 32; t0 = row0; islast = (pi == 511); }
        float* o_ca = a->out + (sb < 0 ? O_CAP + (size_t)l * 2 * DA : O_CAS + (size_t)(l * NSB + sb) * 2 * DA);
        float* o_cb = a->out + (sb < 0 ? O_CBP + (size_t)l * 3 * DB : O_CBS + (size_t)(l * NSB + sb) * 3 * DB);
        float* o_h  = a->out + (sb < 0 ? O_HP + (size_t)l * DB : O_HS + (size_t)(l * NSB + sb) * DB);
        float* o_cc = a->out + (sb < 0 ? O_CCP + (size_t)l * 30 * DC : O_CCS + (size_t)(l * NSB + sb) * 30 * DC);
        if (sb < 0 && t0 >= 30) {
            u32x2 cvr[8], cgr[8];
#pragma unroll
            for (int u = 0; u < 8; ++u) { const int e = tid + NTHR * u;
                if (e < 62 * 64) { const bf16_t* ur = U + (size_t)(row0 - 30 + (e >> 6)) * DIN + 4 * (e & 63); cvr[u] = *(const u32x2*)(ur + COL_CV); cgr[u] = *(const u32x2*)(ur + COL_CG); } }
#pragma unroll
            for (int u = 0; u < 8; ++u) { const int e = tid + NTHR * u;
                if (e < 62 * 64) { f32x4 v; v[0] = bflo(cvr[u].x) * sigm(bflo(cgr[u].x)); v[1] = bfhi(cvr[u].x) * sigm(bfhi(cgr[u].x)); v[2] = bflo(cvr[u].y) * sigm(bflo(cgr[u].y)); v[3] = bfhi(cvr[u].y) * sigm(bfhi(cgr[u].y));
                    *(LAS f32x4*)(vs + 4 * e) = v; } }
        } else
        for (int e = tid; e < (len + 30) * 64; e += NTHR) {
            const int i = e >> 6, q = e & 63, tt = t0 - 30 + i;
            f32x4 v = (f32x4){0.f, 0.f, 0.f, 0.f};
            if (tt >= 0) {
                const bf16_t* ur = U + (size_t)(row0 - 30 + i) * DIN;
                const f32x4 cv = ld_bf4(ur + COL_CV + 4 * q), cg_ = ld_bf4(ur + COL_CG + 4 * q);
#pragma unroll
                for (int z = 0; z < 4; ++z) v[z] = cv[z] * sigm(cg_[z]);
            } else if (sb >= 0) v = *(const f32x4*)(a->in[I_SC] + ((size_t)(l * NSB + sb) * 30 + (30 + tt)) * DC + 4 * q);
            *(LAS f32x4*)(vs + i * 256 + 4 * q) = v;
        }
        if (half == 0) {
            float hc;
            if (sb >= 0) hc = a->in[I_SH][(size_t)(l * NSB + sb) * DB + tid];
            else { hc = 0.f; const int nch = unit;
                int k = 0;
                for (; k + 32 <= nch; k += 32) { float A[32], B[32];
#pragma unroll
                    for (int q = 0; q < 32; ++q) { A[q] = AGG[((size_t)(k + q) * 2) * DB + tid]; B[q] = AGG[((size_t)(k + q) * 2 + 1) * DB + tid]; }
#pragma unroll
                    for (int q = 0; q < 32; ++q) hc = A[q] * hc + B[q]; }
                for (; k + 4 <= nch; k += 4) { float A[4], B[4];
#pragma unroll
                    for (int q = 0; q < 4; ++q) { A[q] = AGG[((size_t)(k + q) * 2) * DB + tid]; B[q] = AGG[((size_t)(k + q) * 2 + 1) * DB + tid]; }
#pragma unroll
                    for (int q = 0; q < 4; ++q) hc = A[q] * hc + B[q]; }
                for (; k < nch; ++k) { const float A = AGG[((size_t)k * 2) * DB + tid], B = AGG[((size_t)k * 2 + 1) * DB + tid]; hc = A * hc + B; } }
            carry[tid] = hc;
        }
        LDS_BARRIER();
        const int i0 = 4 * wave;
        if (i0 < len) {
            const int rb = row0 + i0, tb = t0 + i0;
            const bf16_t* ub = U + (size_t)rb * DIN;
            f32x4 acc[4];
#pragma unroll
            for (int j = 0; j < 4; ++j) acc[j] = *(const f32x4*)bccp;
            {
                const f32x4 z4 = (f32x4){0.f, 0.f, 0.f, 0.f};
                f32x4 pw1 = z4, pw2 = z4, pw3 = z4;
#pragma unroll 1
                for (int q = 0; q < 8; ++q) {
                    const LAS float* wp = wcs + (4 * q) * 256 + c4; const LAS float* vp = vs + (i0 + 4 * q) * 256 + c4;
                    const f32x4 w0 = *(const LAS f32x4*)(wp), w1 = *(const LAS f32x4*)(wp + 256), w2 = *(const LAS f32x4*)(wp + 512), w3 = q < 7 ? *(const LAS f32x4*)(wp + 768) : z4;
                    const f32x4 v0 = *(const LAS f32x4*)(vp), v1 = *(const LAS f32x4*)(vp + 256), v2 = *(const LAS f32x4*)(vp + 512), v3 = *(const LAS f32x4*)(vp + 768);
                    acc[0] += w0 * v0; acc[1] += pw3 * v0; acc[2] += pw2 * v0; acc[3] += pw1 * v0;
                    acc[0] += w1 * v1; acc[1] += w0 * v1;  acc[2] += pw3 * v1; acc[3] += pw2 * v1;
                    acc[0] += w2 * v2; acc[1] += w1 * v2;  acc[2] += w0 * v2;  acc[3] += pw3 * v2;
                    acc[0] += w3 * v3; acc[1] += w2 * v3;  acc[2] += w1 * v3;  acc[3] += w0 * v3;
                    pw1 = w1; pw2 = w2; pw3 = w3;
                }
                const f32x4 v32 = *(const LAS f32x4*)(vs + (i0 + 32) * 256 + c4), v33 = *(const LAS f32x4*)(vs + (i0 + 33) * 256 + c4);
                acc[2] += pw2 * v32; acc[3] += pw1 * v32; acc[3] += pw2 * v33;
            }
            f32x4 pr[6];
#pragma unroll
            for (int m = 0; m < 6; ++m) {
                const int tq = tb - 2 + m;
                if (tq >= 0) { const bf16_t* uq = U + (size_t)(rb - 2 + m) * DIN; pr[m] = ld_bf4(uq + COL_AC + c4) * ld_bf4(uq + COL_AX + c4); }
                else if (sb >= 0) pr[m] = *(const f32x4*)(a->in[I_SA] + ((size_t)(l * NSB + sb) * 2 + (2 + tq)) * DA + c4);
                else pr[m] = (f32x4){0.f, 0.f, 0.f, 0.f};
            }
            u32x2 abr[4];
#pragma unroll
            for (int j = 0; j < 4; ++j) abr[j] = *(const u32x2*)(ub + (size_t)j * DIN + COL_AB + c4);
            u32x4 ha0[4], ha1[4], bgr[4];
#pragma unroll
            for (int j = 0; j < 4; ++j) { ha0[j] = *(const u32x4*)(HLAC + (size_t)(rb + j) * DB + c8); ha1[j] = *(const u32x4*)(HLAC + (size_t)(rb + j) * DB + c8 + 4);
                bgr[j] = *(const u32x4*)(ub + (size_t)j * DIN + COL_BG + c8); }
            f32x4 ya[4], y0[4], y1[4];
            const f32x4 wa0 = *(const f32x4*)wap, wa1 = *(const f32x4*)(wap + DA), wa2 = *(const f32x4*)(wap + 2 * DA);
#pragma unroll
            for (int j = 0; j < 4; ++j) {
                ya[j] = (f32x4){bflo(abr[j].x), bfhi(abr[j].x), bflo(abr[j].y), bfhi(abr[j].y)} * (wa0 * pr[j] + wa1 * pr[j + 1] + wa2 * pr[j + 2]);
                const f32x4 hl0 = (f32x4){bflo(ha0[j].x), bflo(ha0[j].y), bflo(ha0[j].z), bflo(ha0[j].w)}, hl1 = (f32x4){bflo(ha1[j].x), bflo(ha1[j].y), bflo(ha1[j].z), bflo(ha1[j].w)};
                const f32x4 ac0 = (f32x4){bfhi(ha0[j].x), bfhi(ha0[j].y), bfhi(ha0[j].z), bfhi(ha0[j].w)}, ac1 = (f32x4){bfhi(ha1[j].x), bfhi(ha1[j].y), bfhi(ha1[j].z), bfhi(ha1[j].w)};
                const f32x4 h0 = hl0 + ac0 * *(const LAS f32x4*)(carry + c8), h1 = hl1 + ac1 * *(const LAS f32x4*)(carry + c8 + 4);
                const f32x4 g0 = (f32x4){bflo(bgr[j].x), bfhi(bgr[j].x), bflo(bgr[j].y), bfhi(bgr[j].y)}, g1 = (f32x4){bflo(bgr[j].z), bfhi(bgr[j].z), bflo(bgr[j].w), bfhi(bgr[j].w)};
#pragma unroll
                for (int z = 0; z < 4; ++z) { y0[j][z] = h0[z] * gelu_tanh(g0[z]); y1[j][z] = h1[z] * gelu_tanh(g1[z]); }
                if (islast && i0 + j == len - 1) { *(f32x4*)(o_h + c8) = h0; *(f32x4*)(o_h + c8 + 4) = h1; }
            }
            float sC[4], qC[4], qA[4], qB[4];
#pragma unroll
            for (int j = 0; j < 4; ++j) { sC[j] = hsum4(acc[j]); qC[j] = hsq4(acc[j]); qA[j] = hsq4(ya[j]); qB[j] = hsq4(y0[j]) + hsq4(y1[j]); }
#pragma unroll
            for (int hh = 0; hh < 2; ++hh) {
#pragma unroll
                for (int o = 1; o < 64; o <<= 1) { const int idx = (lane ^ o) << 2;
                    float t1[2], t2[2], t3[2], t4[2];
#pragma unroll
                    for (int j = 0; j < 2; ++j) { const int jj = 2 * hh + j;
                        t1[j] = __builtin_bit_cast(float, __builtin_amdgcn_ds_bpermute(idx, __builtin_bit_cast(int, sC[jj]))); t2[j] = __builtin_bit_cast(float, __builtin_amdgcn_ds_bpermute(idx, __builtin_bit_cast(int, qC[jj])));
                        t3[j] = __builtin_bit_cast(float, __builtin_amdgcn_ds_bpermute(idx, __builtin_bit_cast(int, qA[jj]))); t4[j] = __builtin_bit_cast(float, __builtin_amdgcn_ds_bpermute(idx, __builtin_bit_cast(int, qB[jj]))); }
#pragma unroll
                    for (int j = 0; j < 2; ++j) { const int jj = 2 * hh + j; sC[jj] += t1[j]; qC[jj] += t2[j]; qA[jj] += t3[j]; qB[jj] += t4[j]; } }
            }
            float qY[4];
            const f32x4 lng = *(const f32x4*)lngp, lnb = *(const f32x4*)lnbp;
#pragma unroll
            for (int j = 0; j < 4; ++j) {
                const float mu = sC[j] * (1.0f / DC), var = fmaxf(qC[j] * (1.0f / DC) - mu * mu, 0.f);
                f32x4 y = (acc[j] - mu) * __builtin_amdgcn_rsqf(var + EPS) * lng + lnb;
#pragma unroll
                for (int z = 0; z < 4; ++z) y[z] = y[z] * sigm(y[z]);
                acc[j] = y; qY[j] = hsq4(y);
            }
            wave_sum4_l(qY[0], qY[1], qY[2], qY[3], lane);
            const f32x4 gA = *(const f32x4*)(grp + c4), gC = *(const f32x4*)(grp + 768 + c4), gB0 = *(const f32x4*)(grp + 256 + c8), gB1 = *(const f32x4*)(grp + 256 + c8 + 4);
#pragma unroll
            for (int j = 0; j < 4; ++j) {
                const int i = i0 + j;
                bf16_t* yr = Y + (size_t)(rb + j) * D;
                { const f32x4 y = acc[j] * (__builtin_amdgcn_rsqf(qY[j] * (1.0f / DC) + EPS)) * gC; u32x2 o; o.x = pk2(y[0], y[1]); o.y = pk2(y[2], y[3]); *(u32x2*)(yr + 768 + c4) = o; }
                { const f32x4 y = ya[j] * (__builtin_amdgcn_rsqf(qA[j] * (1.0f / DA) + EPS)) * gA; u32x2 o; o.x = pk2(y[0], y[1]); o.y = pk2(y[2], y[3]); *(u32x2*)(yr + c4) = o; }
                { const float rs = __builtin_amdgcn_rsqf(qB[j] * (1.0f / DB) + EPS); const f32x4 a0 = y0[j] * rs * gB0, a1 = y1[j] * rs * gB1;
                  u32x4 o; o.x = pk2(a0[0], a0[1]); o.y = pk2(a0[2], a0[3]); o.z = pk2(a1[0], a1[1]); o.w = pk2(a1[2], a1[3]); *(u32x4*)(yr + 256 + c8) = o; }
                if (islast) {
                    if (i >= len - 2) *(f32x4*)(o_ca + (size_t)(i - (len - 2)) * DA + c4) = pr[j + 2];
                    if (i >= len - 3) { const bf16_t* ur = ub + (size_t)j * DIN; float* ob = o_cb + (size_t)(i - (len - 3)) * DB + c8; *(f32x4*)ob = ld_bf4(ur + COL_BX + c8); *(f32x4*)(ob + 4) = ld_bf4(ur + COL_BX + c8 + 4); }
                }
            }
        }
        if (islast) {
            for (int e = tid; e < 30 * 64; e += NTHR) { const int i = e >> 6, q = e & 63; *(f32x4*)(o_cc + (size_t)i * DC + 4 * q) = *(const LAS f32x4*)(vs + (len + i) * 256 + 4 * q); }
        }
        LDS_BARRIER();
    }
}

#define XB_TMO      128
#define XB_XCNT(j)  (256  + 64 * (j))
#define XB_XSUB(j)  (1280 + 64 * (j))
#define XB_XGEN(j)  (2304 + 64 * (j))
#define XB_TOP      3328
#define XB_TOPGEN   3392
#define XCD_BAR_WORDS 3456
#define XB_SPIN_CAP (1u << 18)

__device__ __forceinline__ unsigned xb_ld(unsigned* p)              { return __hip_atomic_load(p, __ATOMIC_RELAXED, __HIP_MEMORY_SCOPE_AGENT); }
__device__ __forceinline__ unsigned xb_add(unsigned* p, unsigned v) { return __hip_atomic_fetch_add(p, v, __ATOMIC_RELAXED, __HIP_MEMORY_SCOPE_AGENT); }
__device__ __forceinline__ unsigned xb_xcc_id() { return (unsigned)__builtin_amdgcn_s_getreg((3 << 11) | 20) & 0xFu; }
#define XB_SPIN(cond, bar) do { unsigned _sp = 0; while (cond) { __builtin_amdgcn_s_sleep(1); \
    if ((++_sp & 255u) == 0u) { if (xb_ld(&(bar)[XB_TMO])) break; if (_sp > XB_SPIN_CAP) { atomicAdd(&(bar)[XB_TMO], 1u); break; } } } } while (0)

struct XcdBarrier {
    unsigned* bar; unsigned x;
    volatile LAS unsigned* st;
};

__device__ __forceinline__ XcdBarrier xcd_barrier_post(unsigned* bar, volatile LAS unsigned* st) {
    XcdBarrier b; b.bar = bar; b.x = xb_xcc_id(); b.st = st;
    if (threadIdx.x == 0) (void)xb_add(&bar[XB_XCNT(b.x)], 1u);
    return b;
}
__device__ __forceinline__ void xcd_barrier_complete(unsigned* bar, unsigned x, unsigned& nloc, unsigned& nx) {
    const unsigned G = gridDim.x * gridDim.y * gridDim.z;
    unsigned sum, cnt, mine, sp = 0u;
    for (;;) {
        sum = 0u; cnt = 0u; mine = 0u;
#pragma unroll
        for (unsigned j = 0; j < 16; ++j) { const unsigned c = xb_ld(&bar[XB_XCNT(j)]); sum += c; cnt += (c > 0u) ? 1u : 0u; mine = (j == x) ? c : mine; }
        if (sum == G) break;
        __builtin_amdgcn_s_sleep(1);
        if ((++sp & 255u) == 0u) { if (xb_ld(&bar[XB_TMO])) break; if (sp > XB_SPIN_CAP) { atomicAdd(&bar[XB_TMO], 1u); break; } }
    }
    nloc = mine > 0u ? mine : 1u; nx = cnt > 0u ? cnt : 1u;
}

__device__ __forceinline__ void xcd_barrier(const XcdBarrier& b) {
    asm volatile("s_waitcnt vmcnt(0)" ::: "memory");
    __syncthreads();
    if (threadIdx.x == 0) {
        unsigned* bar = b.bar;
        __builtin_amdgcn_s_waitcnt(0);
        unsigned nloc = b.st[0], nx = b.st[1];
        if (nloc == 0u) { xcd_barrier_complete(bar, b.x, nloc, nx); b.st[0] = nloc; b.st[1] = nx; }
        const unsigned old = xb_add(&bar[XB_XSUB(b.x)], 1u);
        const unsigned gen = old / nloc;
        if (old + 1u == (gen + 1u) * nloc) {
            __builtin_amdgcn_fence(__ATOMIC_RELEASE, "agent");
            asm volatile("s_waitcnt vmcnt(0)" ::: "memory");
            const unsigned og = xb_add(&bar[XB_TOP], 1u);
            const unsigned tg = og / nx;
            if (og + 1u == (tg + 1u) * nx) xb_add(&bar[XB_TOPGEN], 1u);
            else XB_SPIN(xb_ld(&bar[XB_TOPGEN]) == tg, bar);
            __builtin_amdgcn_fence(__ATOMIC_ACQUIRE, "agent");
            xb_add(&bar[XB_XGEN(b.x)], 1u);
            asm volatile("s_waitcnt vmcnt(0)" ::: "memory");
        } else {
            XB_SPIN(xb_ld(&bar[XB_XGEN(b.x)]) == gen, bar);
            __builtin_amdgcn_fence(__ATOMIC_ACQUIRE, "agent");
            asm volatile("s_waitcnt vmcnt(0)" ::: "memory");
        }
    }
    __syncthreads();
}

__global__ void __launch_bounds__(NTHR, 2) fwd_kernel(Args a_val) {
    extern __shared__ __attribute__((aligned(16))) unsigned char lds_raw[];
    LAS unsigned char* lds = (LAS unsigned char*)lds_raw;
    unsigned char* ws = a_val.ws;
    volatile LAS unsigned* bst = (volatile LAS unsigned*)(lds + 131072 + 64);
    if (threadIdx.x < 2) bst[threadIdx.x] = 0u;
    __syncthreads();
    const XcdBarrier bar = xcd_barrier_post((unsigned*)ws, bst);
    const float* mod = (const float*)(ws + WS_MOD);
    const int G = gridDim.x;
    for (int step = a_val.ph_lo; step < a_val.ph_hi; ++step) {
        int ph = step;
#if MK_PROBE == 4
        ph = step == 0 ? 0 : step - 1;
#elif MK_PROBE == 2 || MK_PROBE == 3 || MK_PROBE == 5 || MK_PROBE == 6
        if (step >= 2) {
            constexpr unsigned long long TAB = MK_PROBE == 2 ? 0xA98765443210ull : MK_PROBE == 3 ? 0xA98765543210ull : MK_PROBE == 5 ? 0xA9887654332100ull : 0xA9987665432110ull;
            constexpr int LSTEPS = (MK_PROBE == 2 || MK_PROBE == 3) ? 12 : 14;
            const int ls = (step - 2) / LSTEPS, s = (step - 2) % LSTEPS;
            ph = 2 + 11 * ls + (int)((TAB >> (4 * s)) & 15ull);
        }
#endif
        CArgs a = (CArgs)__builtin_amdgcn_kernarg_segment_ptr(); asm volatile("" : "+s"(a));
        int tid = threadIdx.x; asm volatile("" : "+v"(tid));
        const int lane = tid & 63, wave = __builtin_amdgcn_readfirstlane(tid >> 6);
        if (ph == 0) { if (!MK_NO_PRO) phase_prologue(a, lds, tid, lane, wave); }
        else if (ph == 1) phase_rows(a, lane, wave, 0, false, 0.f, 1, mod, 0, a->in[I_NPOST], mod, 1, 0, a->in[I_NPRE]);
        else {
            const int l = (ph - 2) / 11, k = (ph - 2) % 11;
            const float* modl = mod + (size_t)l * 9 * 9216;
            const bool defer_win = (G == 256) && MK_DEFER_WIN;
            if (k == 0 || k == 8 || k == 1 || k == 9 || k == 6 || k == 3 || (k == 4 && defer_win)) {
                pg8::Gemm g; pg8::EpiMulti E; int N;
                const bool n1024 = (k == 1 || k == 6 || k == 9);
                if (k == 0 || k == 8) {
                    g = pg8::Gemm{(const bf16_t*)(ws + WS_H), (const bf16_t*)(ws + WS_W13 + (size_t)(l * 2 + (k == 0 ? 0 : 1)) * W13_BYTES), MP, 2 * DFF, D, D};
                    E = pg8::EpiMulti{0, (void*)(ws + WS_GU), DFF, nullptr, 8}; N = 2 * DFF;
                } else if (k == 6) {
                    g = pg8::Gemm{(const bf16_t*)(ws + WS_Y), (const bf16_t*)(ws + WS_WOUT + (size_t)l * WOUT_BYTES), MP, D, D, D};
                    E = pg8::EpiMulti{2, (void*)(ws + WS_F), D, (void*)(ws + WS_FPART), 8}; N = D;
                } else if (k == 3 || k == 4) {
                    g = pg8::Gemm{(const bf16_t*)(ws + WS_H), (const bf16_t*)(ws + WS_WIN + (size_t)l * WIN_BYTES), MP, DIN, D, D};
                    E = pg8::EpiMulti{2, (void*)(ws + WS_GU), DIN, nullptr, 8}; N = DIN;
                } else {
                    g = pg8::Gemm{(const bf16_t*)(ws + WS_GU), (const bf16_t*)(ws + WS_W2 + (size_t)(l * 2 + (k == 1 ? 0 : 1)) * W2_BYTES), MP, D, DFF, DFF};
                    E = pg8::EpiMulti{2, (void*)(ws + WS_F), D, (void*)(ws + WS_FPART), 8}; N = D;
                }
                const bool stream_tail = n1024 && (G == 256) && MK_STREAM_TAIL;
                const int nparts = (n1024 && !stream_tail) ? 2 : 1;
                for (int part = 0; part < nparts; ++part) {
                    pg8::StaticOrder S;
                    if (k == 3 && defer_win) { S.init(MP, 7 * 256, G, (int)blockIdx.x); S.mode = 1; }
                    else if (k == 4) { S.init(MP, N, G, (int)blockIdx.x - 176); S.mode = 2; }
                    else if (!n1024) S.init(MP, N, G, (int)blockIdx.x);
                    else if (stream_tail) { S.init(TP, N, G, (int)blockIdx.x, 0, 1, 128); S.mode = 3; S.pmx = TP / 256; S.xsplit = g.ld / 128; E.kshift = 7; }
                    else if (part == 0) S.init(TP, N, G, (int)blockIdx.x);
                    else { S.init(256, N, G, (int)blockIdx.x, TP / 256, g.ld / 256, 256); g.K = 256; E = pg8::EpiMulti{4, (void*)(ws + WS_FPART), D, nullptr, 8}; }
                    if (!MK_NO_G1) pg8::gemm_phase<pg8::EpiMulti, pg8::StaticOrder, true, true>(lds, g, S, E);
                }
            }
            if (k == 4) { if (!MK_NO_MIX1) phase_mix1(a, lds, l, tid, lane, wave, defer_win); }
            else if (k == 0 || k == 8 || k == 1 || k == 9 || k == 6 || k == 3) { }
            else if (k == 5) { if (!MK_NO_MIX2) phase_mix2(a, lds, l, tid, lane, wave); }
            else {
                const int sub = k == 2 ? 0 : (k == 7 ? 1 : 2);
                const bool fin = (k == 10 && l == NL - 1);
                const int ln = k == 10 ? (l + 1 < NL ? l + 1 : l) : l, subn = k == 10 ? 0 : sub + 1;
                phase_rows(a, lane, wave, 1, fin, sub == 1 ? 1.0f : 0.5f, (sub == 1 ? D : DFF) / (((G == 256) && MK_STREAM_TAIL) ? 128 : 256), modl, 3 * sub + 2, a->in[I_NPOST] + (size_t)(l * 3 + sub) * D,
                           mod + (size_t)ln * 9 * 9216, 3 * subn + 1, 3 * subn, a->in[I_NPRE] + (size_t)(ln * 3 + subn) * D);
            }
        }
        if (step + 1 < a_val.ph_hi) xcd_barrier(bar);
#if MK_PROBE == 1
        if (step + 1 < a_val.ph_hi) xcd_barrier(bar);
#endif
        if (a_val.ph_hi == -12345) cg::this_grid().sync();
    }
}

#if MK_CHECK
__device__ __forceinline__ float wsum(float v) { for (int o = 32; o > 0; o >>= 1) v += __shfl_xor(v, o); return v; }
__device__ __forceinline__ float bfv(const bf16_t* p) { return __builtin_bit_cast(float, (unsigned)(*p) << 16); }
__device__ __forceinline__ bool isbad(float got, float ref, float rel, float ab) { const float d = fabsf(got - ref); return !(d <= ab + rel * fabsf(ref)); }
__device__ __forceinline__ void fail(unsigned* w, unsigned code) { atomicMin(w, code); }
__device__ float dotA(const bf16_t* Arow, const float* W, int K, int N, int c, int lane) { float s = 0.f; for (int k = lane; k < K; k += 64) s += bfv(Arow + k) * W[(size_t)k * N + c]; return wsum(s); }
__device__ int chk_row(int i) { const int R[6] = {0, 300, 16383, 16384, 16400, 16511}; return i == 0 ? 0 : i == 1 ? 300 : i == 2 ? 16383 : i == 3 ? 16384 : i == 4 ? 16400 : 16511; }
__global__ void chk_kernel(Args a, int stage) {
    const int lane = threadIdx.x, s = blockIdx.x;
    unsigned char* ws = a.ws; unsigned* word = (unsigned*)(ws + 32768);
    const float* mod = (const float*)(ws + WS_MOD);
    const float* Xb = (const float*)(ws + WS_X); const bf16_t* H = (const bf16_t*)(ws + WS_H); const bf16_t* Fb = (const bf16_t*)(ws + WS_F);
    const bf16_t* GU = (const bf16_t*)(ws + WS_GU); const bf16_t* Y = (const bf16_t*)(ws + WS_Y);
    const int r = chk_row(s % 6), bidx = r < TP ? 0 : 1 + ((r - TP) >> 4);
    const int cs = s / 6;
    if (stage == 1) {
        { const int b = (s * 3) % 9, n = (s * 1531 + 7) % 9216; float acc = 0.f;
          for (int k = lane; k < 1024; k += 64) { const float c = b == 0 ? a.in[I_CP][k] : a.in[I_CS][(b - 1) * 1024 + k]; acc += c / (1.f + expf(-c)) * a.in[I_WADA][(size_t)k * 9216 + n]; }
          acc = wsum(acc) + a.in[I_BADA][n];
          const float got = mod[(size_t)b * 9216 + n], d = fabsf(got - acc);
          if (isbad(got, acc, 1e-3f, 1e-3f)) fail(word, 1); }
        { const int c = (s * 401 + 130) % DFF, row = (c >> 7) * 256 + (c & 127); const bf16_t* WT = (const bf16_t*)(ws + WS_W13);
          for (int k = lane; k < 1024; k += 64) { if (isbad(bfv(WT + (size_t)row * 1024 + k), a.in[I_W1][(size_t)k * DFF + c], 0.01f, 1e-6f)) fail(word, 2);
                                                  if (isbad(bfv(WT + (size_t)(row + 128) * 1024 + k), a.in[I_W3][(size_t)k * DFF + c], 0.01f, 1e-6f)) fail(word, 3); } }
        { const int c = (s * 211 + 513) % D; const bf16_t* WT = (const bf16_t*)(ws + WS_W2);
          for (int k = lane; k < DFF; k += 64) if (isbad(bfv(WT + (size_t)c * DFF + k), a.in[I_W2][(size_t)k * D + c], 0.01f, 1e-6f)) fail(word, 4); }
        { const int c = (s * 577 + 2303) % DIN; const bf16_t* WT = (const bf16_t*)(ws + WS_WIN);
          for (int k = lane; k < D; k += 64) if (isbad(bfv(WT + (size_t)c * D + k), a.in[I_WIN][(size_t)k * DIN + c], 0.01f, 1e-6f)) fail(word, 5); }
        { const int c = (s * 311 + 1023) % D; const bf16_t* WT = (const bf16_t*)(ws + WS_WOUT);
          for (int k = lane; k < D; k += 64) if (isbad(bfv(WT + (size_t)c * D + k), a.in[I_WOUT][(size_t)k * D + c], 0.01f, 1e-6f)) fail(word, 6); }
        { const int c = (s * 401 + 130) % DFF, row = (c >> 7) * 256 + (c & 127); const bf16_t* WT = (const bf16_t*)(ws + WS_W13 + 7 * W13_BYTES);
          for (int k = lane; k < 1024; k += 64) if (isbad(bfv(WT + (size_t)(row + 128) * 1024 + k), a.in[I_W3][(size_t)7 * D * DFF + (size_t)k * DFF + c], 0.01f, 1e-6f)) fail(word, 7); }
    } else if (stage == 2 || stage == 5 || stage == 9) {
        const float* xin = r < TP ? a.in[I_XP] + (size_t)r * D : a.in[I_XS] + (size_t)(r - TP) * D;
        float ssx = 0.f;
        for (int c = lane; c < D; c += 64) ssx += Xb[(size_t)r * D + c] * Xb[(size_t)r * D + c];
        const float rstdx = 1.f / sqrtf(wsum(ssx) / D + EPS);
        if (stage == 2) { for (int c = lane; c < D; c += 64) if (isbad(Xb[(size_t)r * D + c], xin[c], 1e-6f, 1e-6f)) fail(word, 8); }
        if (stage == 5) { float ssf = 0.f; for (int c = lane; c < D; c += 64) { const float f = bfv(Fb + (size_t)r * D + c); ssf += f * f; }
            const float rstdf = 1.f / sqrtf(wsum(ssf) / D + EPS);
            for (int c = lane; c < D; c += 64) { const float ref = xin[c] + 0.5f * mod[((size_t)bidx * 9 + 2) * D + c] * bfv(Fb + (size_t)r * D + c) * rstdf * a.in[I_NPOST][c];
                if (isbad(Xb[(size_t)r * D + c], ref, 1e-3f, 1e-3f)) fail(word, 11); } }
        const int sub = stage == 2 ? 0 : (stage == 5 ? 1 : 2);
        for (int c = lane; c < D; c += 64) { const float ref = Xb[(size_t)r * D + c] * rstdx * a.in[I_NPRE][sub * D + c] * (1.f + mod[((size_t)bidx * 9 + 3 * sub + 1) * D + c]) + mod[((size_t)bidx * 9 + 3 * sub) * D + c];
            if (isbad(bfv(H + (size_t)r * D + c), ref, 0.01f, 0.01f)) fail(word, stage == 2 ? 9 : (stage == 5 ? 12 : 24)); }
    } else if (stage == 3) {
        const int c = (cs * 937 + 130 * (s % 6)) % DFF;
        const float a1 = dotA(H + (size_t)r * D, a.in[I_W1], D, DFF, c, lane), a3 = dotA(H + (size_t)r * D, a.in[I_W3], D, DFF, c, lane);
        const float ref = a1 / (1.f + expf(-a1)) * a3;
        if (isbad(bfv(GU + (size_t)r * DFF + c), ref, 0.03f, 0.03f)) fail(word, 10);
    } else if (stage == 4) {
        const int c = (cs * 341 + 513 * (s % 6)) % D;
        const float ref = dotA(GU + (size_t)r * DFF, a.in[I_W2], DFF, D, c, lane);
        if (isbad(bfv(Fb + (size_t)r * D + c), ref, 0.03f, 0.03f)) fail(word, 13);
    } else if (stage == 6) {
        const int c = (cs * 601 + 255 * (s % 6) + 1) % DIN;
        const float ref = dotA(H + (size_t)r * D, a.in[I_WIN], D, DIN, c, lane);
        if (isbad(bfv(GU + (size_t)r * DIN + c), ref, 0.03f, 0.03f)) fail(word, 14);
    } else if (stage == 8) {
        const int c = (cs * 341 + 513 * (s % 6)) % D;
        const float ref = dotA(Y + (size_t)r * D, a.in[I_WOUT], D, D, c, lane);
        if (isbad(bfv(Fb + (size_t)r * D + c), ref, 0.03f, 0.03f)) fail(word, 23);
    } else if (stage == 7) {
        if (s < 6) {
            const bool smp = s >= 3; const int sbb = s - 3;
            const int rl = smp ? TP + 16 * sbb + 15 : TP - 1;
            for (int c = lane; c < DA; c += 64) { const bf16_t* u = GU + (size_t)rl * DIN; const float ref = bfv(u + COL_AC + c) * bfv(u + COL_AX + c);
                const float got = a.out[(smp ? O_CAS + (size_t)sbb * 2 * DA : O_CAP) + DA + c]; if (isbad(got, ref, 1e-3f, 1e-4f)) fail(word, 15); }
            for (int c = lane; c < DB; c += 64) { const float ref = bfv(GU + (size_t)(rl - 2) * DIN + COL_BX + c);
                const float got = a.out[(smp ? O_CBS + (size_t)sbb * 3 * DB : O_CBP) + c]; if (isbad(got, ref, 1e-3f, 1e-4f)) fail(word, 16); }
            for (int c = lane; c < DC; c += 64) { const bf16_t* u = GU + (size_t)(rl - 3) * DIN; const float ref = bfv(u + COL_CV + c) / (1.f + expf(-bfv(u + COL_CG + c)));
                const float got = a.out[(smp ? O_CCS + (size_t)sbb * 30 * DC : O_CCP) + 26 * DC + c]; if (isbad(got, ref, 2e-3f, 1e-4f)) fail(word, 17); }
            if (smp) { for (int c = lane; c < DC; c += 64) { const float ref = a.in[I_SC][((size_t)sbb * 30 + 20) * DC + c];
                const float got = a.out[O_CCS + (size_t)sbb * 30 * DC + 4 * DC + c]; if (isbad(got, ref, 1e-5f, 1e-6f)) fail(word, 18); } }
        } else if (s < 12) {
            const int which = s - 6; const bool smp = which >= 3; const int sbb = which - 3;
            const int ch = (which * 97 + 5) % DB, head = ch >> 6, ci = 64 * head + lane;
            const int T = smp ? 16 : TP, rbase = smp ? TP + 16 * sbb : 0;
            float h = smp ? a.in[I_SH][(size_t)sbb * DB + ch] : 0.f;
            const float wrl = a.in[I_WGR][((size_t)head * 64 + lane) * 64 + (ch & 63)], wil = a.in[I_WGI][((size_t)head * 64 + lane) * 64 + (ch & 63)];
            const float lam = a.in[I_LAM][ch], lsg = -log1pf(expf(-lam));
            float xm3, xm2, xm1;
            if (smp) { xm3 = a.in[I_SB][((size_t)sbb * 3 + 0) * DB + ci]; xm2 = a.in[I_SB][((size_t)sbb * 3 + 1) * DB + ci]; xm1 = a.in[I_SB][((size_t)sbb * 3 + 2) * DB + ci]; } else { xm3 = xm2 = xm1 = 0.f; }
            const float w0 = a.in[I_WCB][0 * DB + ci], w1 = a.in[I_WCB][1 * DB + ci], w2 = a.in[I_WCB][2 * DB + ci], w3 = a.in[I_WCB][3 * DB + ci], bc = a.in[I_BCB][ci];
            float h100 = 0.f, h63 = 0.f;
            for (int t = 0; t < T; ++t) {
                const float x0 = bfv(GU + (size_t)(rbase + t) * DIN + COL_BX + ci);
                const float xb = bc + w0 * xm3 + w1 * xm2 + w2 * xm1 + w3 * x0; xm3 = xm2; xm2 = xm1; xm1 = x0;
                const float rp = wsum(xb * wrl) + a.in[I_BGR][ch], ip = wsum(xb * wil) + a.in[I_BGI][ch];
                const float xbc = __shfl(xb, ch & 63);
                const float rr = 1.f / (1.f + expf(-rp)), ii = 1.f / (1.f + expf(-ip));
                const float la = 8.f * rr * lsg, av = expf(la);
                h = av * h + sqrtf(-expm1f(2.f * la)) * ii * xbc;
                if (t == 63) h63 = h; if (t == 100) h100 = h;
            }
            const float got = a.out[(smp ? O_HS + (size_t)sbb * DB : O_HP) + ch];
            if (isbad(got, h, 0.02f, 0.003f)) fail(word, smp ? 19 : 20);
            if (!smp) { const float* HL = (const float*)(ws + WS_HL); const float* AC = (const float*)(ws + WS_AC);
                if (isbad(HL[(size_t)63 * DB + ch], h63, 0.01f, 0.002f)) fail(word, 21);
                if (isbad(HL[(size_t)100 * DB + ch] + AC[(size_t)100 * DB + ch] * h63, h100, 0.01f, 0.002f)) fail(word, 22); }
        }
    }
}
__global__ void chk_report(Args a) { const unsigned w = *(unsigned*)(a.ws + 32768); if (w != 0x7f7f7f7fu) a.out[0] = 100.0f * (float)w; }
#endif
}

extern "C" void kernel_launch(void* const* d_in, const int* in_sizes, int n_in, void* d_out, int out_size, void* d_ws, size_t ws_size, hipStream_t stream) {
    using namespace mk;
    static int grid = 0;
    if (grid == 0) {
        if (n_in != 30 || (size_t)out_size != O_END || ws_size < WS_END) { fprintf(stderr, "kernel_launch: unexpected shapes (n_in %d out %d ws %zu)\n", n_in, out_size, ws_size); grid = -1; return; }
        int dev = 0, cus = 0, per_cu = 0;
        if (hipGetDevice(&dev) != hipSuccess || hipDeviceGetAttribute(&cus, hipDeviceAttributeMultiprocessorCount, dev) != hipSuccess) { grid = -1; return; }
        if (hipFuncSetAttribute((const void*)fwd_kernel, hipFuncAttributeMaxDynamicSharedMemorySize, LDS_BYTES) != hipSuccess) { fprintf(stderr, "kernel_launch: hipFuncSetAttribute failed\n"); grid = -1; return; }
        if (hipOccupancyMaxActiveBlocksPerMultiprocessor(&per_cu, (const void*)fwd_kernel, NTHR, LDS_BYTES) != hipSuccess || per_cu < 1) { fprintf(stderr, "kernel_launch: occupancy query gave %d\n", per_cu); per_cu = 1; }
        (void)hipGetLastError();
        grid = cus * 1;
    }
    if (grid < 0) return;
    if (hipMemsetAsync(d_ws, 0, 16384, stream) != hipSuccess) { fprintf(stderr, "kernel_launch: memset failed\n"); return; }
    Args a{};
    for (int i = 0; i < 30; ++i) a.in[i] = (const float*)d_in[i];
    a.out = (float*)d_out; a.ws = (unsigned char*)d_ws;
#if MK_ONE_LAUNCH
    a.ph_lo = 0; a.ph_hi = NSTEP;
    void* args[] = {&a};
    hipError_t e = hipLaunchCooperativeKernel((const void*)fwd_kernel, dim3(grid), dim3(NTHR), args, LDS_BYTES, stream);
    if (e != hipSuccess) fprintf(stderr, "kernel_launch: cooperative launch failed: %s (grid %d)\n", hipGetErrorString(e), grid);
#else
#if MK_CHECK
    hipMemsetAsync((char*)d_ws + 32768, 0x7f, 256, stream);
#endif
    for (int ph = 0; ph < NPH; ++ph) {
        a.ph_lo = ph; a.ph_hi = ph + 1;
        hipLaunchKernelGGL(fwd_kernel, dim3(grid), dim3(NTHR), LDS_BYTES, stream, a);
#if MK_CHECK
        const int stg = ph == 0 ? 1 : ph == 1 ? 2 : ph == 2 ? 3 : ph == 3 ? 4 : ph == 4 ? 5 : ph == 5 ? 6 : ph == 7 ? 7 : ph == 8 ? 8 : ph == 9 ? 9 : 0;
        if (stg) hipLaunchKernelGGL(chk_kernel, dim3(24), dim3(64), 0, stream, a, stg);
#endif
    }
#if MK_CHECK
    hipLaunchKernelGGL(chk_report, dim3(1), dim3(1), 0, stream, a);
#endif
#endif
}
```

```cpp
#include <hip/hip_runtime.h>
#include <hip/hip_cooperative_groups.h>
#include <cstdio>
#include <cstdint>
namespace cg = cooperative_groups;
namespace pg8 {
#define PG8_LAS __attribute__((address_space(3)))
typedef unsigned short bf16_t;
typedef short bf16x8 __attribute__((ext_vector_type(8)));
typedef float f32x4 __attribute__((ext_vector_type(4)));
typedef unsigned u32x4 __attribute__((ext_vector_type(4)));
constexpr int BM = 256, BK = 64, HALF = 128, HTB = HALF * BK * 2  , STAGE_BYTES = 8 * HTB, NXCD = 8, WGM = 8;

__host__ __device__ __forceinline__ int lds_byte(int r, int c) { const int st = (r >> 4) * 2 + (c >> 5), rr = r & 15, cc = c & 31, ob = rr * 64 + cc * 2; return st * 1024 + (ob ^ (((ob >> 9) & 1) << 5)); }
__host__ __device__ __forceinline__ void stage_rc(int b, int& R, int& C) { const int st = b / 1024, sb = b % 1024, swz = sb ^ (((sb >> 9) & 1) << 5); R = (st >> 1) * 16 + swz / 64; C = (st & 1) * 32 + (swz % 64) / 2; }
__host__ __device__ __forceinline__ int perm32(int rho) { const int n = rho >> 4, i = rho & 15; return 8 * (i >> 2) + 4 * n + (i & 3); }

struct Unit { int pm, pn, ko, nt, sp; };
struct Gemm { const bf16_t* A; const bf16_t* Bt; int M, N, K, ld; };

struct StaticOrder {
    int nM, nN, nwg, G, c, pm0, nsplit, klen, mode, pmx, xsplit;
    __host__ __device__ void init(int M, int N, int G_, int c_, int pm0_ = 0, int nsplit_ = 1, int klen_ = 0) { nM = M / BM; nN = N / BM; nwg = nM * nN; G = G_; c = c_; pm0 = pm0_; nsplit = nsplit_; klen = klen_; mode = 0; }
    __host__ __device__ bool next(int i, Unit& u) const {
        const long L = (long)i * G + c;
        if (mode == 3 && i >= 1) { if (i > 1 || c >= nN * xsplit) return false; u.pm = pmx; u.pn = c % nN; u.ko = (c / nN) * klen; u.nt = klen / BK; u.sp = 1; return true; }
        if (mode == 3) { if (L >= nwg) return false; }
        if (nsplit > 1) { if (L >= (long)nN * nsplit) return false; u.pm = pm0; u.pn = (int)(L % nN); u.ko = (int)(L / nN) * klen; u.nt = 0; u.sp = 1; return true; }
        if (mode == 2) { if (i > 0 || c < 0 || c >= 80) return false; if (c < 65) { u.pm = c; u.pn = 8; } else { u.pm = 50 + (c - 65); u.pn = 7; } u.ko = 0; u.nt = 0; u.sp = 0; return true; }
        if (mode == 1 && L >= nwg) { const long Lp = L - nwg; if (Lp >= 50) return false; u.pm = (int)Lp; u.pn = 7; u.ko = 0; u.nt = 0; u.sp = 0; return true; }
        if (L >= nwg) return false;
        int wgid = (int)L; { const int q = nwg / NXCD, r = nwg % NXCD, xcd = wgid % NXCD, off = wgid / NXCD; wgid = (xcd < r ? xcd * (q + 1) : r * (q + 1) + (xcd - r) * q) + off; }
        const int nig = WGM * nN, gid = wgid / nig, fm = gid * WGM, gsz = (nM - fm) < WGM ? (nM - fm) : WGM;
        u.pm = pm0 + fm + ((wgid % nig) % gsz); u.pn = (wgid % nig) / gsz; u.ko = 0; u.nt = 0; u.sp = 0; return true;
    }
    __device__ __forceinline__ void a_ready(const Unit&) const {}
    __device__ __forceinline__ void done(const Unit&) const {}
};

__device__ __forceinline__ unsigned cvt_pk_bf16(float lo, float hi) { unsigned r; asm volatile("v_cvt_pk_bf16_f32 %0, %1, %2" : "=v"(r) : "v"(lo), "v"(hi)); return r; }
typedef float f32x2 __attribute__((ext_vector_type(2)));
__device__ __forceinline__ float fast_sigmoid(float x) { return __builtin_amdgcn_rcpf(1.0f + __builtin_amdgcn_exp2f(-1.44269504089f * x)); }
struct EpiSwiGLU {
    static constexpr bool PERM = true, AFTER_DRAIN = false;
    bf16_t* O; int ldc;
    __device__ __forceinline__ void operator()(const f32x4 (&acc)[2][2][4][2], const Unit& u, int wr, int wc, int fr, int fq) const {
        const int row0 = u.pm * BM + wr * 64 + fr, col0 = u.pn * HALF + wc * 32 + 8 * fq;
#pragma unroll
        for (int ai = 0; ai < 2; ++ai)
#pragma unroll
            for (int m = 0; m < 4; ++m) {
                bf16_t* rowp = O + (size_t)(row0 + ai * HALF + m * 16) * ldc + col0;
                f32x4 g0, g1;
#pragma unroll
                for (int e = 0; e < 4; ++e) {
                    const float a0 = acc[ai][0][m][0][e], a1 = acc[ai][0][m][1][e];
                    g0[e] = a0 * fast_sigmoid(a0) * acc[ai][1][m][0][e];
                    g1[e] = a1 * fast_sigmoid(a1) * acc[ai][1][m][1][e];
                }
                u32x4 w; w.x = cvt_pk_bf16(g0[0], g0[1]); w.y = cvt_pk_bf16(g0[2], g0[3]); w.z = cvt_pk_bf16(g1[0], g1[1]); w.w = cvt_pk_bf16(g1[2], g1[3]);
                *(u32x4*)rowp = w;
            }
    }
};
struct EpiF32 {
    static constexpr bool PERM = true, AFTER_DRAIN = false;
    float* O; int ldc;
    __device__ __forceinline__ void operator()(const f32x4 (&acc)[2][2][4][2], const Unit& u, int wr, int wc, int fr, int fq) const {
        const int row0 = u.pm * BM + wr * 64 + fr, col0 = u.pn * BM + wc * 32 + 8 * fq;
#pragma unroll
        for (int ai = 0; ai < 2; ++ai)
#pragma unroll
            for (int m = 0; m < 4; ++m) {
                float* rowp = O + (size_t)(row0 + ai * HALF + m * 16) * ldc + col0;
#pragma unroll
                for (int bj = 0; bj < 2; ++bj) { *(f32x4*)(rowp + bj * HALF) = acc[ai][bj][m][0]; *(f32x4*)(rowp + bj * HALF + 4) = acc[ai][bj][m][1]; }
            }
    }
};
struct EpiB16 {
    static constexpr bool PERM = true, AFTER_DRAIN = false;
    bf16_t* O; int ldc;
    __device__ __forceinline__ void operator()(const f32x4 (&acc)[2][2][4][2], const Unit& u, int wr, int wc, int fr, int fq) const {
        const int row0 = u.pm * BM + wr * 64 + fr, col0 = u.pn * BM + wc * 32 + 8 * fq;
#pragma unroll
        for (int ai = 0; ai < 2; ++ai)
#pragma unroll
            for (int m = 0; m < 4; ++m) {
                bf16_t* rowp = O + (size_t)(row0 + ai * HALF + m * 16) * ldc + col0;
#pragma unroll
                for (int bj = 0; bj < 2; ++bj) { const f32x4 v0 = acc[ai][bj][m][0], v1 = acc[ai][bj][m][1];
                    u32x4 w; w.x = cvt_pk_bf16(v0[0], v0[1]); w.y = cvt_pk_bf16(v0[2], v0[3]); w.z = cvt_pk_bf16(v1[0], v1[1]); w.w = cvt_pk_bf16(v1[2], v1[3]);
                    *(u32x4*)(rowp + bj * HALF) = w; }
            }
    }
};

struct EpiMulti {
    static constexpr bool PERM = true, AFTER_DRAIN = false;
    int mode; void* O; int ldc; void* O2; int kshift;
    __device__ __forceinline__ void operator()(const f32x4 (&acc)[2][2][4][2], const Unit& u, int wr, int wc, int fr, int fq) const {
        if (u.sp && mode == 2) { Unit v = u; v.pm = u.ko >> kshift; EpiB16 e{(bf16_t*)O2, ldc}; e(acc, v, wr, wc, fr, fq); }
        else if (mode == 0) { EpiSwiGLU e{(bf16_t*)O, ldc}; e(acc, u, wr, wc, fr, fq); }
        else if (mode == 4) { Unit v = u; v.pm = u.ko >> 8; EpiB16 e{(bf16_t*)O, ldc}; e(acc, v, wr, wc, fr, fq); }
        else { EpiB16 e{(bf16_t*)O, ldc}; e(acc, u, wr, wc, fr, fq); }
    }
};
template <class Epi, class Sched, bool ALIGN_EPI = false, bool SP2 = false>
__device__ __forceinline__ void gemm_phase(PG8_LAS unsigned char* lds, const Gemm g, const Sched& S, const Epi& E) {
    const int tid = threadIdx.x, wid = __builtin_amdgcn_readfirstlane(tid >> 6), lane = tid & 63, wr = wid >> 2, wc = wid & 3, fr = lane & 15, fq = lane >> 4;
    const int K = g.ld; int nt = g.K / BK;
    unsigned voffA[2], voffB[2];
#pragma unroll
    for (int i = 0; i < 2; ++i) { int R, C; stage_rc(tid * 16 + i * 8192, R, C); const int Rb = Epi::PERM ? ((R & ~31) + perm32(R & 31)) : R;
        voffA[i] = (unsigned)(R * K + C) * 2u; voffB[i] = (unsigned)(Rb * K + C) * 2u; }
    const size_t kstep = (size_t)(BK * 2);
    const size_t hstep = (size_t)HALF * K * 2;
    const size_t tstep = 2 * hstep;
    const unsigned ldsw = (unsigned)wid * 1024u;
    const int aoff = lds_byte(wr * 64 + fr, fq * 8), boff = lds_byte(wc * 32 + fr, fq * 8);
#define PG8_SA(b, h) (((b) * 2 + (h)) * HTB)
#define PG8_SB(b, h) ((4 + (b) * 2 + (h)) * HTB)
#define PG8_STAGE(bufoff, gbase, voff) do { _Pragma("unroll") for (int _i = 0; _i < 2; ++_i) \
        __builtin_amdgcn_global_load_lds((const unsigned*)((const char*)(gbase) + (voff)[_i]), (PG8_LAS unsigned*)(lds + (bufoff) + ldsw + _i * 8192), 16, 0, 0); } while (0)
#define PG8_LDA(dst, b, h) do { _Pragma("unroll") for (int m = 0; m < 4; ++m) _Pragma("unroll") for (int k = 0; k < 2; ++k) dst[m][k] = *(const PG8_LAS bf16x8*)(lds + PG8_SA(b, h) + aoff + m * 2048 + k * 1024); } while (0)
#define PG8_LDB(dst, b, h) do { _Pragma("unroll") for (int n = 0; n < 2; ++n) _Pragma("unroll") for (int k = 0; k < 2; ++k) dst[n][k] = *(const PG8_LAS bf16x8*)(lds + PG8_SB(b, h) + boff + n * 2048 + k * 1024); } while (0)
#define PG8_MMA(ai, bj, At, Bt) do { __builtin_amdgcn_s_setprio(1); _Pragma("unroll") for (int m = 0; m < 4; ++m) _Pragma("unroll") for (int n = 0; n < 2; ++n) _Pragma("unroll") for (int k = 0; k < 2; ++k) \
        acc[ai][bj][m][n] = __builtin_amdgcn_mfma_f32_16x16x32_bf16(Bt[n][k], At[m][k], acc[ai][bj][m][n], 0, 0, 0); __builtin_amdgcn_s_setprio(0); } while (0)
#define PG8_WAIT_V(n) asm volatile("s_waitcnt vmcnt(" #n ")" ::: "memory")
#define PG8_WAIT_L(n) asm volatile("s_waitcnt lgkmcnt(" #n ")" ::: "memory")
#define PG8_BAR __builtin_amdgcn_s_barrier()
#define PG8_SCHED __builtin_amdgcn_sched_barrier(0)
    Unit cur, nxt; int ui = 0;
    if (!S.next(0, cur)) return;
    if (cur.nt > 0) nt = cur.nt;
    f32x4 acc[2][2][4][2];
#pragma unroll
    for (int a = 0; a < 2; ++a)
#pragma unroll
        for (int b = 0; b < 2; ++b)
#pragma unroll
            for (int m = 0; m < 4; ++m)
#pragma unroll
                for (int n = 0; n < 2; ++n) acc[a][b][m][n] = (f32x4){0.f, 0.f, 0.f, 0.f};
    bf16x8 At[4][2], B0[2][2], B1[2][2];
    const char* cA = (const char*)g.A + (size_t)cur.pm * tstep + (size_t)cur.ko * 2; const char* cB = (const char*)g.Bt + (size_t)cur.pn * tstep + (size_t)cur.ko * 2;
    S.a_ready(cur);
    if constexpr (SP2) {
        PG8_STAGE(PG8_SB(0, 0), cB, voffB); PG8_STAGE(PG8_SB(0, 1), cB + hstep, voffB); PG8_STAGE(PG8_SA(0, 0), cA, voffA); PG8_STAGE(PG8_SA(0, 1), cA + hstep, voffA);
        if (wr == 1) PG8_BAR;
        PG8_WAIT_V(2); PG8_BAR;
        PG8_STAGE(PG8_SB(1, 0), cB + kstep, voffB); PG8_STAGE(PG8_SA(1, 0), cA + kstep, voffA); PG8_STAGE(PG8_SB(1, 1), cB + hstep + kstep, voffB);
        PG8_WAIT_V(6); PG8_BAR;
    } else {
        PG8_STAGE(PG8_SB(0, 0), cB, voffB); PG8_STAGE(PG8_SA(0, 0), cA, voffA); PG8_STAGE(PG8_SB(0, 1), cB + hstep, voffB); PG8_STAGE(PG8_SA(0, 1), cA + hstep, voffA);
        if (wr == 1) PG8_BAR;
        PG8_WAIT_V(4); PG8_BAR;
        PG8_STAGE(PG8_SB(1, 0), cB + kstep, voffB); PG8_STAGE(PG8_SA(1, 0), cA + kstep, voffA); PG8_STAGE(PG8_SB(1, 1), cB + hstep + kstep, voffB);
        PG8_WAIT_V(6); PG8_BAR;
    }
    for (;;) {
        const bool has_next = S.next(ui + 1, nxt);
        const char* nA = has_next ? (const char*)g.A + (size_t)nxt.pm * tstep + (size_t)nxt.ko * 2 : cA; const char* nB = has_next ? (const char*)g.Bt + (size_t)nxt.pn * tstep + (size_t)nxt.ko * 2 : cB;
        for (int t = 0; t < nt; t += 2) {
            const bool last = (t == nt - 2);
            const char* a1 = cA + (size_t)(t + 1) * kstep;
            const char* a2 = last ? nA : cA + (size_t)(t + 2) * kstep; const char* b2 = last ? nB : cB + (size_t)(t + 2) * kstep;
            const char* a3 = a2 + kstep; const char* b3 = b2 + kstep;
            if (last && has_next) S.a_ready(nxt);
            if constexpr (SP2) {
            PG8_LDB(B0, 0, 0); PG8_LDB(B1, 0, 1); PG8_SCHED; PG8_LDA(At, 0, 0); PG8_STAGE(PG8_SA(1, 1), a1 + hstep, voffA);
            PG8_WAIT_V(8); PG8_WAIT_L(0); PG8_BAR; PG8_MMA(0, 0, At, B0); PG8_MMA(0, 1, At, B1); PG8_BAR; PG8_SCHED;
            PG8_LDA(At, 0, 1); PG8_STAGE(PG8_SB(0, 0), b2, voffB); PG8_STAGE(PG8_SB(0, 1), b2 + hstep, voffB); PG8_STAGE(PG8_SA(0, 0), a2, voffA);
            PG8_WAIT_V(8); PG8_WAIT_L(0); PG8_BAR; PG8_MMA(1, 0, At, B0); PG8_MMA(1, 1, At, B1); PG8_BAR; PG8_SCHED;
            PG8_LDB(B0, 1, 0); PG8_LDB(B1, 1, 1); PG8_SCHED; PG8_LDA(At, 1, 0); PG8_STAGE(PG8_SA(0, 1), a2 + hstep, voffA);
            PG8_WAIT_V(8); PG8_WAIT_L(0); PG8_BAR; PG8_MMA(0, 0, At, B0); PG8_MMA(0, 1, At, B1); PG8_BAR; PG8_SCHED;
            PG8_LDA(At, 1, 1); PG8_STAGE(PG8_SB(1, 0), b3, voffB); PG8_STAGE(PG8_SB(1, 1), b3 + hstep, voffB); PG8_STAGE(PG8_SA(1, 0), a3, voffA);
            PG8_WAIT_V(8); PG8_WAIT_L(0); PG8_BAR; PG8_MMA(1, 0, At, B0); PG8_MMA(1, 1, At, B1); PG8_BAR; PG8_SCHED;
            } else {
            PG8_LDB(B0, 0, 0); PG8_SCHED; PG8_LDA(At, 0, 0); PG8_STAGE(PG8_SA(1, 1), a1 + hstep, voffA);
            PG8_WAIT_L(8); PG8_BAR; PG8_WAIT_L(0); PG8_MMA(0, 0, At, B0); PG8_BAR; PG8_SCHED;
            PG8_LDB(B1, 0, 1); PG8_STAGE(PG8_SB(0, 0), b2, voffB);
            PG8_BAR; PG8_WAIT_L(0); PG8_MMA(0, 1, At, B1); PG8_BAR;
            PG8_LDA(At, 0, 1); PG8_STAGE(PG8_SA(0, 0), a2, voffA);
            PG8_BAR; PG8_WAIT_L(0); PG8_MMA(1, 0, At, B0); PG8_BAR; PG8_SCHED;
            PG8_STAGE(PG8_SB(0, 1), b2 + hstep, voffB);
            PG8_WAIT_V(6); PG8_BAR; PG8_MMA(1, 1, At, B1); PG8_BAR;
            PG8_LDB(B0, 1, 0); PG8_SCHED; PG8_LDA(At, 1, 0); PG8_STAGE(PG8_SA(0, 1), a2 + hstep, voffA);
            PG8_WAIT_L(8); PG8_BAR; PG8_WAIT_L(0); PG8_MMA(0, 0, At, B0); PG8_BAR; PG8_SCHED;
            PG8_LDB(B1, 1, 1); PG8_STAGE(PG8_SB(1, 0), b3, voffB);
            PG8_BAR; PG8_WAIT_L(0); PG8_MMA(0, 1, At, B1); PG8_BAR;
            PG8_LDA(At, 1, 1); PG8_STAGE(PG8_SA(1, 0), a3, voffA);
            PG8_BAR; PG8_WAIT_L(0); PG8_MMA(1, 0, At, B0); PG8_BAR; PG8_SCHED;
            PG8_STAGE(PG8_SB(1, 1), b3 + hstep, voffB);
            PG8_WAIT_V(6); PG8_BAR; PG8_MMA(1, 1, At, B1); PG8_BAR;
            }
        }
        if constexpr (ALIGN_EPI) { if (wr == 0) PG8_BAR; }
        if constexpr (!Epi::AFTER_DRAIN) { E(acc, cur, wr, wc, fr, fq); S.done(cur); }
        if (!has_next) break;
#pragma unroll
        for (int a = 0; a < 2; ++a)
#pragma unroll
            for (int b = 0; b < 2; ++b)
#pragma unroll
                for (int m = 0; m < 4; ++m)
#pragma unroll
                    for (int n = 0; n < 2; ++n) acc[a][b][m][n] = (f32x4){0.f, 0.f, 0.f, 0.f};
        cur = nxt; cA = nA; cB = nB; ++ui; if (cur.nt > 0) nt = cur.nt;
        if constexpr (ALIGN_EPI) { if (wr == 1) PG8_BAR; }
    }
    PG8_WAIT_V(0);
    if constexpr (!ALIGN_EPI) { if (wr == 0) PG8_BAR; }
    PG8_BAR;
    if constexpr (Epi::AFTER_DRAIN) { E.fused(acc, cur, wr, wc, fr, fq, lds, wid, lane); S.done(cur); }
#undef PG8_SA
#undef PG8_SB
#undef PG8_STAGE
#undef PG8_LDA
#undef PG8_LDB
#undef PG8_MMA
#undef PG8_WAIT_V
#undef PG8_WAIT_L
#undef PG8_BAR
#undef PG8_SCHED
}
}

#ifndef MK_NO_PRO
#define MK_NO_PRO 0
#endif
#ifndef MK_NO_MIX1
#define MK_NO_MIX1 0
#endif
#ifndef MK_NO_MIX2
#define MK_NO_MIX2 0
#endif
#ifndef MK_NO_G1
#define MK_NO_G1 0
#endif
#ifndef MK_NO_G2
#define MK_NO_G2 0
#endif
#ifndef MK_NO_G3
#define MK_NO_G3 0
#endif
#ifndef MK_CHECK
#define MK_CHECK 0
#endif
#ifndef MK_PROBE
#define MK_PROBE 0
#endif
#ifndef MK_DEFER_WIN
#define MK_DEFER_WIN 1
#endif
#ifndef MK_STREAM_TAIL
#define MK_STREAM_TAIL 1
#endif
#ifndef MK_ONE_LAUNCH
#define MK_ONE_LAUNCH 1
#endif
namespace mk {
#define LAS __attribute__((address_space(3)))
typedef unsigned short bf16_t;
typedef float f32x4 __attribute__((ext_vector_type(4)));
typedef unsigned u32x4 __attribute__((ext_vector_type(4)));
typedef unsigned u32x2 __attribute__((ext_vector_type(2)));
constexpr int NWAVES = 8, NTHR = 512;
constexpr int D = 1024, TP = 16384, NSB = 8, TSS = 16, MV = 16512, MP = 16640, DFF = 2816, DIN = 2304, NL = 4;
constexpr int DA = 256, DB = 512, DC = 256;
constexpr int COL_AB = 0, COL_AC = 256, COL_AX = 512, COL_BX = 768, COL_BG = 1280, COL_CV = 1792, COL_CG = 2048;
constexpr float EPS = 1e-6f;
constexpr int LDS_BYTES = 147456;
constexpr size_t MiB = 1u << 20;
constexpr size_t WS_W13 = 1 * MiB, WS_W2 = 89 * MiB, WS_WIN = 133 * MiB, WS_WOUT = 151 * MiB, WS_MOD = 159 * MiB, WS_AGG = 161 * MiB,
                 WS_X = 163 * MiB, WS_F = 228 * MiB, WS_H = 293 * MiB, WS_Y = 326 * MiB, WS_HL = 359 * MiB, WS_AC = 392 * MiB, WS_GU = 425 * MiB, WS_FPART = 515 * MiB, WS_END = 527 * MiB;
constexpr size_t W13_BYTES = (size_t)2 * DFF * D * 2, W2_BYTES = (size_t)D * DFF * 2, WIN_BYTES = (size_t)DIN * D * 2, WOUT_BYTES = (size_t)D * D * 2;
constexpr size_t O_Y = 0, O_CAP = 16908288, O_CBP = 16910336, O_HP = 16916480, O_CCP = 16918528, O_CAS = 16949248, O_CBS = 16965632, O_HS = 17014784, O_CCS = 17031168, O_END = 17276928;
constexpr int NPH = 2 + 11 * NL;
constexpr int NSTEP = MK_PROBE == 4 ? NPH + 1 : (MK_PROBE == 2 || MK_PROBE == 3) ? 2 + 12 * NL : (MK_PROBE == 5 || MK_PROBE == 6) ? 2 + 14 * NL : NPH;
constexpr int NCHUNK = 256 + NSB;

struct Args { const float* in[30]; float* out; unsigned char* ws; int ph_lo, ph_hi; };
typedef const __attribute__((address_space(4))) Args* CArgs;
enum { I_XP = 0, I_XS, I_SA, I_SB, I_SH, I_SC, I_CP, I_CS, I_WADA, I_BADA, I_NPRE, I_NPOST, I_W1, I_W3, I_W2, I_WIN, I_WOUT, I_WCA, I_WCB, I_BCB,
       I_WGR, I_BGR, I_WGI, I_BGI, I_LAM, I_WCC, I_BCC, I_LNG, I_LNB, I_GRP };

__device__ __forceinline__ float wave_sum_l(float v, int lane) {
#pragma unroll
    for (int o = 1; o < 64; o <<= 1) v += __builtin_bit_cast(float, __builtin_amdgcn_ds_bpermute((lane ^ o) << 2, __builtin_bit_cast(int, v)));
    return v;
}
#define wave_sum(v) wave_sum_l((v), lane)
#define LDS_BARRIER() do { asm volatile("s_waitcnt lgkmcnt(0)" ::: "memory"); __builtin_amdgcn_s_barrier(); asm volatile("" ::: "memory"); } while (0)
__device__ __forceinline__ void wave_sum4_l(float& a, float& b, float& c, float& d, int lane) {
#pragma unroll
    for (int o = 1; o < 64; o <<= 1) { const int idx = (lane ^ o) << 2;
        const float a2 = __builtin_bit_cast(float, __builtin_amdgcn_ds_bpermute(idx, __builtin_bit_cast(int, a))), b2 = __builtin_bit_cast(float, __builtin_amdgcn_ds_bpermute(idx, __builtin_bit_cast(int, b)));
        const float c2 = __builtin_bit_cast(float, __builtin_amdgcn_ds_bpermute(idx, __builtin_bit_cast(int, c))), d2 = __builtin_bit_cast(float, __builtin_amdgcn_ds_bpermute(idx, __builtin_bit_cast(int, d)));
        a += a2; b += b2; c += c2; d += d2; }
}
__device__ __forceinline__ unsigned f2bf(float f) { unsigned u = __builtin_bit_cast(unsigned, f); return (u + 0x7fffu + ((u >> 16) & 1u)) >> 16; }
__device__ __forceinline__ unsigned pk2(float lo, float hi) { unsigned r; asm("v_cvt_pk_bf16_f32 %0, %1, %2" : "=v"(r) : "v"(lo), "v"(hi)); return r; }
__device__ __forceinline__ float bflo(unsigned u) { return __builtin_bit_cast(float, u << 16); }
__device__ __forceinline__ float bfhi(unsigned u) { return __builtin_bit_cast(float, u & 0xffff0000u); }
__device__ __forceinline__ f32x4 ld_bf4(const bf16_t* p) { const u32x2 v = *(const u32x2*)p; return (f32x4){bflo(v.x), bfhi(v.x), bflo(v.y), bfhi(v.y)}; }
__device__ __forceinline__ float bf1(const bf16_t* p) { return __builtin_bit_cast(float, (unsigned)(*p) << 16); }
__device__ __forceinline__ float sigm(float x) { return __builtin_amdgcn_rcpf(1.0f + __builtin_amdgcn_exp2f(-1.44269504089f * x)); }
__device__ __forceinline__ float gelu_tanh(float x) { return x * sigm(1.5957691216f * (x + 0.044715f * x * x * x)); }
__device__ __forceinline__ float hsum4(f32x4 v) { return (v[0] + v[1]) + (v[2] + v[3]); }
__device__ __forceinline__ float hsq4(f32x4 v) { return (v[0] * v[0] + v[1] * v[1]) + (v[2] * v[2] + v[3] * v[3]); }

__device__ __forceinline__ void transpose_item(const float* W, int K, int N, bf16_t* WT, LAS float* scr, int kb, int nb, int dst_row0, int lane) {
    const int k0 = 64 * kb, n0 = 32 * nb;
#pragma unroll 8
    for (int i = 0; i < 32; ++i) { const int kk = 2 * i + (lane >> 5); scr[kk * 33 + (lane & 31)] = W[(size_t)(k0 + kk) * N + n0 + (lane & 31)]; }
    asm volatile("s_waitcnt lgkmcnt(0)" ::: "memory");
    const int c = lane & 7;
#pragma unroll
    for (int j = 0; j < 4; ++j) { const int n = (lane >> 3) + 8 * j; const LAS float* s = scr + (8 * c) * 33 + n;
        u32x4 o; o.x = pk2(s[0 * 33], s[1 * 33]); o.y = pk2(s[2 * 33], s[3 * 33]); o.z = pk2(s[4 * 33], s[5 * 33]); o.w = pk2(s[6 * 33], s[7 * 33]);
        *(u32x4*)(WT + (size_t)(dst_row0 + n) * K + k0 + 8 * c) = o; }
    asm volatile("s_waitcnt lgkmcnt(0)" ::: "memory");
}

__device__ __forceinline__ void phase_prologue(CArgs a, LAS unsigned char* lds, int tid, int lane, int wave) {
    unsigned char* ws = a->ws;
    {
        LAS float* sc = (LAS float*)lds;
        LAS float* red = sc + 9 * 1024;
        for (int e = tid; e < 9 * 1024; e += NTHR) { const int b = e >> 10, k = e & 1023; const float c = b == 0 ? a->in[I_CP][k] : a->in[I_CS][(b - 1) * 1024 + k]; sc[e] = c * sigm(c); }
        __syncthreads();
        float* mod = (float*)(ws + WS_MOD);
        const int kk = tid >> 5, cl = tid & 31;
        for (int u = blockIdx.x; u < NL * 72; u += gridDim.x) {
            const int l = u / 72, n0 = 128 * (u % 72);
            f32x4 acc[9];
#pragma unroll
            for (int b = 0; b < 9; ++b) acc[b] = (f32x4){0.f, 0.f, 0.f, 0.f};
            const float* wp = a->in[I_WADA] + (size_t)l * 1024 * 9216 + n0 + 4 * cl;
#pragma unroll 4
            for (int k = kk; k < 1024; k += 16) {
                const f32x4 w = *(const f32x4*)(wp + (size_t)k * 9216);
#pragma unroll
                for (int b = 0; b < 9; ++b) acc[b] += sc[b * 1024 + k] * w;
            }
#pragma unroll
            for (int b = 0; b < 9; ++b)
#pragma unroll
                for (int e = 0; e < 4; ++e) { const float av = acc[b][e]; acc[b][e] = av + __builtin_bit_cast(float, __builtin_amdgcn_ds_bpermute((lane ^ 32) << 2, __builtin_bit_cast(int, av))); }
            if (lane < 32) {
#pragma unroll
                for (int b = 0; b < 9; ++b) *(LAS f32x4*)(red + (wave * 9 + b) * 128 + 4 * cl) = acc[b];
            }
            __syncthreads();
            for (int o = tid; o < 9 * 128; o += NTHR) {
                const int b = o >> 7, c = o & 127; float s = 0.f;
#pragma unroll
                for (int w = 0; w < 8; ++w) s += red[(w * 9 + b) * 128 + c];
                mod[((size_t)l * 9 + b) * 9216 + n0 + c] = s + a->in[I_BADA][l * 9216 + n0 + c];
            }
            __syncthreads();
        }
    }
    __syncthreads();
    {
        LAS float* scr = (LAS float*)(lds + wave * 8448);
        const int gw = blockIdx.x * NWAVES + wave, NGW = gridDim.x * NWAVES;
        constexpr int I13 = 16 * 88, I2 = 44 * 32, IIN = 16 * 72, IOUT = 16 * 32;
        constexpr int PER_L = 4 * I13 + 2 * I2 + IIN + IOUT;
        for (int it = gw; it < NL * PER_L; it += NGW) {
            const int l = it / PER_L; int r = it % PER_L;
            if (r < 4 * I13) {
                const int which = r / (2 * I13); r %= 2 * I13; const int s = r / I13, q = r % I13, kb = q / 88, nb = q % 88;
                const float* W = a->in[which ? I_W3 : I_W1] + (size_t)(l * 2 + s) * D * DFF;
                bf16_t* WT = (bf16_t*)(ws + WS_W13 + (size_t)(l * 2 + s) * W13_BYTES);
                const int n0 = 32 * nb, dst = (n0 >> 7) * 256 + (n0 & 127) + (which ? 128 : 0);
                transpose_item(W, D, DFF, WT, scr, kb, nb, dst, lane);
                continue;
            }
            r -= 4 * I13;
            if (r < 2 * I2) {
                const int s = r / I2, q = r % I2, kb = q / 32, nb = q % 32;
                transpose_item(a->in[I_W2] + (size_t)(l * 2 + s) * DFF * D, DFF, D, (bf16_t*)(ws + WS_W2 + (size_t)(l * 2 + s) * W2_BYTES), scr, kb, nb, 32 * nb, lane);
                continue;
            }
            r -= 2 * I2;
            if (r < IIN) { const int kb = r / 72, nb = r % 72;
                transpose_item(a->in[I_WIN] + (size_t)l * D * DIN, D, DIN, (bf16_t*)(ws + WS_WIN + (size_t)l * WIN_BYTES), scr, kb, nb, 32 * nb, lane); continue; }
            r -= IIN;
            { const int kb = r / 32, nb = r % 32;
                transpose_item(a->in[I_WOUT] + (size_t)l * D * D, D, D, (bf16_t*)(ws + WS_WOUT + (size_t)l * WOUT_BYTES), scr, kb, nb, 32 * nb, lane); }
        }
    }
}

__device__ __forceinline__ void phase_rows(CArgs a, int lane, int wave, int mode, bool final_, float coef, int nsplit,
                                           const float* modc, int gidx, const float* gpost, const float* modn, int scidx, int shidx, const float* gpre) {
    unsigned char* ws = a->ws;
    bf16_t* X = (bf16_t*)(ws + WS_X); const bf16_t* Fb = (const bf16_t*)(ws + WS_F); bf16_t* H = (bf16_t*)(ws + WS_H);
    const int gw = blockIdx.x * NWAVES + wave, NGW = gridDim.x * NWAVES;
    {
        f32x4 gg[4], gs[4], tt[4];
#pragma unroll
        for (int j = 0; j < 4; ++j) { const int c = 4 * lane + 256 * j;
            gg[j] = mode ? coef * *(const f32x4*)(modc + (size_t)gidx * D + c) * *(const f32x4*)(gpost + c) : (f32x4){0.f, 0.f, 0.f, 0.f};
            gs[j] = *(const f32x4*)(gpre + c) * (1.0f + *(const f32x4*)(modn + (size_t)scidx * D + c));
            tt[j] = *(const f32x4*)(modn + (size_t)shidx * D + c); }
        const float* xin = a->in[I_XP];
        constexpr int LA = 3;
        u32x2 xq[LA + 1][4], fq[LA + 1][4]; f32x4 xf[LA + 1][4];
#define ROWS_LOAD(S_, R_) do { if ((R_) < TP) { _Pragma("unroll") for (int j = 0; j < 4; ++j) { const size_t o_ = (size_t)(R_) * D + 4 * lane + 256 * j; \
            if (mode) { xq[S_][j] = *(const u32x2*)(X + o_); fq[S_][j] = *(const u32x2*)(Fb + o_); } else xf[S_][j] = *(const f32x4*)(xin + o_); } } } while (0)
        int r = gw;
        ROWS_LOAD(0, r); ROWS_LOAD(1, r + NGW); ROWS_LOAD(2, r + 2 * NGW);
        while (r < TP) {
            ROWS_LOAD(3, r + 3 * NGW);
            f32x4 x[4];
            if (mode) {
                f32x4 f[4]; float ss = 0.f;
#pragma unroll
                for (int j = 0; j < 4; ++j) { f[j] = (f32x4){bflo(fq[0][j].x), bfhi(fq[0][j].x), bflo(fq[0][j].y), bfhi(fq[0][j].y)}; ss += hsq4(f[j]); }
                const float rstd = __builtin_amdgcn_rsqf(wave_sum(ss) * (1.0f / D) + EPS);
#pragma unroll
                for (int j = 0; j < 4; ++j) x[j] = (f32x4){bflo(xq[0][j].x), bfhi(xq[0][j].x), bflo(xq[0][j].y), bfhi(xq[0][j].y)} + gg[j] * (f[j] * rstd);
            } else {
#pragma unroll
                for (int j = 0; j < 4; ++j) x[j] = xf[0][j];
            }
            if (final_) {
#pragma unroll
                for (int j = 0; j < 4; ++j) *(f32x4*)(a->out + (size_t)r * D + 4 * lane + 256 * j) = x[j];
            } else {
                float ss = 0.f;
#pragma unroll
                for (int j = 0; j < 4; ++j) { u32x2 xo; xo.x = pk2(x[j][0], x[j][1]); xo.y = pk2(x[j][2], x[j][3]); *(u32x2*)(X + (size_t)r * D + 4 * lane + 256 * j) = xo;
                    x[j] = (f32x4){bflo(xo.x), bfhi(xo.x), bflo(xo.y), bfhi(xo.y)}; ss += hsq4(x[j]); }
                const float rstd = __builtin_amdgcn_rsqf(wave_sum(ss) * (1.0f / D) + EPS);
#pragma unroll
                for (int j = 0; j < 4; ++j) { const f32x4 h = (x[j] * rstd) * gs[j] + tt[j];
                    u32x2 o; o.x = pk2(h[0], h[1]); o.y = pk2(h[2], h[3]);
                    *(u32x2*)(H + (size_t)r * D + 4 * lane + 256 * j) = o; }
            }
#pragma unroll
            for (int s = 0; s < LA; ++s)
#pragma unroll
                for (int j = 0; j < 4; ++j) { xq[s][j] = xq[s + 1][j]; fq[s][j] = fq[s + 1][j]; xf[s][j] = xf[s + 1][j]; }
            r += NGW;
        }
#undef ROWS_LOAD
    }
    const int sstride = (NGW % (MV - TP) == 0) ? NGW / (MV - TP) : 1;
    for (int r = (gw % sstride == 0) ? TP + gw / sstride : MV; r < MV; r += NGW / sstride) {
        const int bidx = 1 + ((r - TP) >> 4);
        f32x4 x[4];
        if (mode == 0) {
            const float* src = a->in[I_XS] + (size_t)(r - TP) * D;
#pragma unroll
            for (int j = 0; j < 4; ++j) x[j] = *(const f32x4*)(src + 4 * lane + 256 * j);
        } else {
            f32x4 f[4]; float ss = 0.f;
#pragma unroll
            for (int j = 0; j < 4; ++j) {
                u32x2 pr[22];
#pragma unroll
                for (int s = 0; s < 22; ++s) pr[s] = s < nsplit ? *(const u32x2*)((const bf16_t*)(ws + WS_FPART) + ((size_t)s * 256 + (r - TP)) * D + 4 * lane + 256 * j) : (u32x2){0u, 0u};
                f[j] = (f32x4){0.f, 0.f, 0.f, 0.f};
#pragma unroll
                for (int s = 0; s < 22; ++s) f[j] += (f32x4){bflo(pr[s].x), bfhi(pr[s].x), bflo(pr[s].y), bfhi(pr[s].y)};
                ss += hsq4(f[j]); }
#pragma unroll
            for (int j = 0; j < 4; ++j) x[j] = ld_bf4(X + (size_t)r * D + 4 * lane + 256 * j);
            const float rstd = coef * __builtin_amdgcn_rsqf(wave_sum(ss) * (1.0f / D) + EPS);
            const float* gate = modc + ((size_t)bidx * 9 + gidx) * D;
#pragma unroll
            for (int j = 0; j < 4; ++j) { const f32x4 g = *(const f32x4*)(gate + 4 * lane + 256 * j), gp = *(const f32x4*)(gpost + 4 * lane + 256 * j);
                x[j] += g * (f[j] * rstd * gp); }
        }
        if (final_) {
#pragma unroll
            for (int j = 0; j < 4; ++j) *(f32x4*)(a->out + (size_t)r * D + 4 * lane + 256 * j) = x[j];
        } else {
            float ss = 0.f;
#pragma unroll
            for (int j = 0; j < 4; ++j) { u32x2 xo; xo.x = pk2(x[j][0], x[j][1]); xo.y = pk2(x[j][2], x[j][3]); *(u32x2*)(X + (size_t)r * D + 4 * lane + 256 * j) = xo;
                x[j] = (f32x4){bflo(xo.x), bfhi(xo.x), bflo(xo.y), bfhi(xo.y)}; ss += hsq4(x[j]); }
            const float rstd = __builtin_amdgcn_rsqf(wave_sum(ss) * (1.0f / D) + EPS);
            const float* sc = modn + ((size_t)bidx * 9 + scidx) * D; const float* sh = modn + ((size_t)bidx * 9 + shidx) * D;
#pragma unroll
            for (int j = 0; j < 4; ++j) { const int c = 4 * lane + 256 * j;
                const f32x4 g = *(const f32x4*)(gpre + c), s = *(const f32x4*)(sc + c), t = *(const f32x4*)(sh + c);
                const f32x4 h = (x[j] * rstd * g) * (1.0f + s) + t;
                u32x2 o; o.x = pk2(h[0], h[1]); o.y = pk2(h[2], h[3]);
                *(u32x2*)(H + (size_t)r * D + c) = o; }
        }
    }
}

typedef short bf16x8v __attribute__((ext_vector_type(8)));
typedef float f32x16 __attribute__((ext_vector_type(16)));
__device__ __forceinline__ void phase_mix1(CArgs a, LAS unsigned char* lds, int l, int tid, int lane, int wave, bool defer_win) {
    unsigned char* ws = a->ws;
    const bf16_t* U = (const bf16_t*)(ws + WS_GU);
    float* AGG = (float*)(ws + WS_AGG);
    LAS bf16_t* XB = (LAS bf16_t*)lds;
    LAS bf16_t* WT = XB + 64 * 72;
    LAS float* PRE = (LAS float*)(WT + 2 * 64 * 72);
    LAS float* comb = PRE + 2 * 64 * 64;
    const int j = lane, tg = wave;
    const int mg = wave & 1, mtb = (wave >> 1) & 1, mjb = wave >> 2, mr = lane & 31, mh = lane >> 5;
    float wcb[4];
    float br = 0.f, bi = 0.f, lsig = 0.f, bcb = 0.f;
    int cur_head = -1;
    unsigned* HLAC = (unsigned*)(ws + WS_HL);
    float bx[11];
    unsigned short rawu[11]; float raws[11];
#define MIX1_ISSUE(W_) do { const int head_ = (W_) & 7, chunk_ = (W_) >> 3, chg_ = 64 * head_ + j; const bool smp_ = chunk_ >= 256; \
        const int sb_ = smp_ ? chunk_ - 256 : 0, row0_ = smp_ ? TP + TSS * sb_ : 64 * chunk_; \
        const float* sbp_ = a->in[I_SB] + (size_t)(l * NSB + sb_) * 3 * DB + chg_; \
        _Pragma("unroll") for (int q = 0; q < 11; ++q) { const int t_ = tg * 8 - 3 + q; int ru_ = row0_ + t_; \
            ru_ = ru_ < 0 ? 0 : (ru_ > MV - 1 ? MV - 1 : ru_); int si_ = 3 + t_; si_ = si_ < 0 ? 0 : (si_ > 2 ? 2 : si_); \
            rawu[q] = U[(size_t)ru_ * DIN + COL_BX + chg_]; raws[q] = sbp_[(size_t)si_ * DB]; } \
        __builtin_amdgcn_sched_barrier(0); } while (0)
#define MIX1_CONSUME(W_) do { const int chunk_ = (W_) >> 3; const bool smp_ = chunk_ >= 256; \
        const int row0_ = smp_ ? TP + TSS * (chunk_ - 256) : 64 * chunk_, len_ = smp_ ? TSS : 64; \
        _Pragma("unroll") for (int q = 0; q < 11; ++q) { const int t_ = tg * 8 - 3 + q; const int ru_ = row0_ + t_; \
            const bool uok_ = (t_ < len_) && (ru_ >= 0) && (t_ >= 0 || !smp_), sok_ = smp_ && t_ < 0; \
            bx[q] = __builtin_bit_cast(float, (unsigned)rawu[q] << 16) * (uok_ ? 1.0f : 0.0f) + raws[q] * (sok_ ? 1.0f : 0.0f); } } while (0)
    int w0 = (int)blockIdx.x, wstep = (int)gridDim.x, wend = 8 * NCHUNK;
    if (defer_win) { const int hd = (int)blockIdx.x & 7, rk = (int)blockIdx.x >> 3;
        if (rk < 22) { w0 = rk * 8 + hd; wstep = 22 * 8; wend = 214 * 8; } else { w0 = (214 + rk - 22) * 8 + hd; wstep = 10 * 8; wend = 8 * NCHUNK; } }
    if (w0 < wend) MIX1_ISSUE(w0);
    for (int w = w0; w < wend; w += wstep) {
        const int head = w & 7, chunk = w >> 3, chg = 64 * head + j;
        if (head != cur_head) {
            cur_head = head;
            LDS_BARRIER();
            const float* pr = a->in[I_WGR] + (size_t)(l * 8 + head) * 4096; const float* pi = a->in[I_WGI] + (size_t)(l * 8 + head) * 4096;
            for (int e = tid; e < 4096; e += NTHR) { const int k = e >> 6, jj = e & 63; WT[jj * 72 + k] = (bf16_t)f2bf(pr[e]); WT[64 * 72 + jj * 72 + k] = (bf16_t)f2bf(pi[e]); }
            br = a->in[I_BGR][l * DB + chg]; bi = a->in[I_BGI][l * DB + chg];
            const float lam = a->in[I_LAM][l * DB + chg]; lsig = -log1pf(expf(-lam));
#pragma unroll
            for (int k = 0; k < 4; ++k) wcb[k] = a->in[I_WCB][(l * 4 + k) * DB + chg];
            bcb = a->in[I_BCB][l * DB + chg];
        }
        int row0, len;
        if (chunk < 256) { row0 = 64 * chunk; len = 64; } else { row0 = TP + TSS * (chunk - 256); len = TSS; }
        MIX1_CONSUME(w);
        float xb[8];
#pragma unroll
        for (int i = 0; i < 8; ++i) { xb[i] = bcb + wcb[0] * bx[i] + wcb[1] * bx[i + 1] + wcb[2] * bx[i + 2] + wcb[3] * bx[i + 3]; XB[(tg * 8 + i) * 72 + j] = (bf16_t)f2bf(xb[i]); }
        LDS_BARRIER();
        if (w + wstep < wend) MIX1_ISSUE(w + wstep);
        {
            f32x16 acc;
#pragma unroll
            for (int i = 0; i < 16; ++i) acc[i] = 0.f;
#pragma unroll
            for (int ks = 0; ks < 4; ++ks) {
                const bf16x8v av = *(const LAS bf16x8v*)(XB + (mtb * 32 + mr) * 72 + ks * 16 + 8 * mh);
                const bf16x8v bv = *(const LAS bf16x8v*)(WT + mg * 64 * 72 + (mjb * 32 + mr) * 72 + ks * 16 + 8 * mh);
                acc = __builtin_amdgcn_mfma_f32_32x32x16_bf16(av, bv, acc, 0, 0, 0);
            }
#pragma unroll
            for (int i = 0; i < 16; ++i) PRE[(mg * 64 + mtb * 32 + (i & 3) + 8 * (i >> 2) + 4 * mh) * 64 + mjb * 32 + mr] = acc[i];
        }
        LDS_BARRIER();
        float hl[8], ac[8]; float Ac = 1.f, hc = 0.f;
#pragma unroll
        for (int t = 0; t < 8; ++t) {
            if (tg * 8 + t < len) {
                const float r = sigm(br + PRE[(tg * 8 + t) * 64 + j]), ig = sigm(bi + PRE[(64 + tg * 8 + t) * 64 + j]);
                const float la = 8.0f * r * lsig, av = __expf(la);
                const float bt = __builtin_amdgcn_sqrtf(fmaxf(1.0f - av * av, 0.f)) * ig * xb[t];
                hc = av * hc + bt; Ac *= av;
            }
            hl[t] = hc; ac[t] = Ac;
        }
        comb[(tg * 2 + 0) * 64 + j] = Ac; comb[(tg * 2 + 1) * 64 + j] = hc;
        LDS_BARRIER();
        float Ap = 1.f, Hp = 0.f;
        for (int g = 0; g < tg; ++g) { const float Ag = comb[(g * 2) * 64 + j], Hg = comb[(g * 2 + 1) * 64 + j]; Hp = Ag * Hp + Hg; Ap *= Ag; }
#pragma unroll
        for (int t = 0; t < 8; ++t) {
            if (tg * 8 + t < len) HLAC[(size_t)(row0 + tg * 8 + t) * DB + chg] = pk2(hl[t] + ac[t] * Hp, ac[t] * Ap);
        }
        if (tg == 7) { AGG[((size_t)chunk * 2 + 0) * DB + chg] = ac[7] * Ap; AGG[((size_t)chunk * 2 + 1) * DB + chg] = hl[7] + ac[7] * Hp; }
        LDS_BARRIER();
    }
#undef MIX1_ISSUE
#undef MIX1_CONSUME
}

__device__ __forceinline__ void phase_mix2(CArgs a, LAS unsigned char* lds, int l, int tid, int lane, int wave) {
    unsigned char* ws = a->ws;
    const bf16_t* U = (const bf16_t*)(ws + WS_GU); bf16_t* Y = (bf16_t*)(ws + WS_Y);
    const unsigned* HLAC = (const unsigned*)(ws + WS_HL); const float* AGG = (const float*)(ws + WS_AGG);
    LAS float* vs = (LAS float*)lds;
    LAS float* carry = vs + 62 * 256;
    const int c4 = 4 * lane, c8 = 8 * lane;
    LAS float* wcs = carry + 512;
    for (int e = tid; e < 31 * 64; e += NTHR) *(LAS f32x4*)(wcs + 4 * e) = *(const f32x4*)(a->in[I_WCC] + (size_t)l * 31 * DC + 4 * e);
    const float* bccp = a->in[I_BCC] + l * DC + c4; const float* lngp = a->in[I_LNG] + l * DC + c4; const float* lnbp = a->in[I_LNB] + l * DC + c4;
    const float* grp = a->in[I_GRP] + l * D;
    const float* wap = a->in[I_WCA] + (size_t)l * 3 * DA + c4;
    for (int unit = blockIdx.x; unit < 256 + NSB; unit += gridDim.x)
    for (int half = 0; half < (unit < 256 ? 2 : 1); ++half) {
        int row0, len, t0, sb = -1; bool islast;
        if (unit >= 256) { sb = unit - 256; row0 = TP + TSS * sb; len = TSS; t0 = 0; islast = true; }
        else { const int pi = 2 * unit + half; row0 = 32 * pi; len = 32; t0 = row0; islast = (pi == 511); }
        float* o_ca = a->out + (sb < 0 ? O_CAP + (size_t)l * 2 * DA : O_CAS + (size_t)(l * NSB + sb) * 2 * DA);
        float* o_cb = a->out + (sb < 0 ? O_CBP + (size_t)l * 3 * DB : O_CBS + (size_t)(l * NSB + sb) * 3 * DB);
        float* o_h  = a->out + (sb < 0 ? O_HP + (size_t)l * DB : O_HS + (size_t)(l * NSB + sb) * DB);
        float* o_cc = a->out + (sb < 0 ? O_CCP + (size_t)l * 30 * DC : O_CCS + (size_t)(l * NSB + sb) * 30 * DC);
        if (sb < 0 && t0 >= 30) {
            u32x2 cvr[8], cgr[8];
#pragma unroll
            for (int u = 0; u < 8; ++u) { const int e = tid + NTHR * u;
                if (e < 62 * 64) { const bf16_t* ur = U + (size_t)(row0 - 30 + (e >> 6)) * DIN + 4 * (e & 63); cvr[u] = *(const u32x2*)(ur + COL_CV); cgr[u] = *(const u32x2*)(ur + COL_CG); } }
#pragma unroll
            for (int u = 0; u < 8; ++u) { const int e = tid + NTHR * u;
                if (e < 62 * 64) { f32x4 v; v[0] = bflo(cvr[u].x) * sigm(bflo(cgr[u].x)); v[1] = bfhi(cvr[u].x) * sigm(bfhi(cgr[u].x)); v[2] = bflo(cvr[u].y) * sigm(bflo(cgr[u].y)); v[3] = bfhi(cvr[u].y) * sigm(bfhi(cgr[u].y));
                    *(LAS f32x4*)(vs + 4 * e) = v; } }
        } else
        for (int e = tid; e < (len + 30) * 64; e += NTHR) {
            const int i = e >> 6, q = e & 63, tt = t0 - 30 + i;
            f32x4 v = (f32x4){0.f, 0.f, 0.f, 0.f};
            if (tt >= 0) {
                const bf16_t* ur = U + (size_t)(row0 - 30 + i) * DIN;
                const f32x4 cv = ld_bf4(ur + COL_CV + 4 * q), cg_ = ld_bf4(ur + COL_CG + 4 * q);
#pragma unroll
                for (int z = 0; z < 4; ++z) v[z] = cv[z] * sigm(cg_[z]);
            } else if (sb >= 0) v = *(const f32x4*)(a->in[I_SC] + ((size_t)(l * NSB + sb) * 30 + (30 + tt)) * DC + 4 * q);
            *(LAS f32x4*)(vs + i * 256 + 4 * q) = v;
        }
        if (half == 0) {
            float hc;
            if (sb >= 0) hc = a->in[I_SH][(size_t)(l * NSB + sb) * DB + tid];
            else { hc = 0.f; const int nch = unit;
                int k = 0;
                for (; k + 32 <= nch; k += 32) { float A[32], B[32];
#pragma unroll
                    for (int q = 0; q < 32; ++q) { A[q] = AGG[((size_t)(k + q) * 2) * DB + tid]; B[q] = AGG[((size_t)(k + q) * 2 + 1) * DB + tid]; }
#pragma unroll
                    for (int q = 0; q < 32; ++q) hc = A[q] * hc + B[q]; }
                for (; k + 4 <= nch; k += 4) { float A[4], B[4];
#pragma unroll
                    for (int q = 0; q < 4; ++q) { A[q] = AGG[((size_t)(k + q) * 2) * DB + tid]; B[q] = AGG[((size_t)(k + q) * 2 + 1) * DB + tid]; }
#pragma unroll
                    for (int q = 0; q < 4; ++q) hc = A[q] * hc + B[q]; }
                for (; k < nch; ++k) { const float A = AGG[((size_t)k * 2) * DB + tid], B = AGG[((size_t)k * 2 + 1) * DB + tid]; hc = A * hc + B; } }
            carry[tid] = hc;
        }
        LDS_BARRIER();
        const int i0 = 4 * wave;
        if (i0 < len) {
            const int rb = row0 + i0, tb = t0 + i0;
            const bf16_t* ub = U + (size_t)rb * DIN;
            f32x4 acc[4];
#pragma unroll
            for (int j = 0; j < 4; ++j) acc[j] = *(const f32x4*)bccp;
            {
                const f32x4 z4 = (f32x4){0.f, 0.f, 0.f, 0.f};
                f32x4 pw1 = z4, pw2 = z4, pw3 = z4;
#pragma unroll 1
                for (int q = 0; q < 8; ++q) {
                    const LAS float* wp = wcs + (4 * q) * 256 + c4; const LAS float* vp = vs + (i0 + 4 * q) * 256 + c4;
                    const f32x4 w0 = *(const LAS f32x4*)(wp), w1 = *(const LAS f32x4*)(wp + 256), w2 = *(const LAS f32x4*)(wp + 512), w3 = q < 7 ? *(const LAS f32x4*)(wp + 768) : z4;
                    const f32x4 v0 = *(const LAS f32x4*)(vp), v1 = *(const LAS f32x4*)(vp + 256), v2 = *(const LAS f32x4*)(vp + 512), v3 = *(const LAS f32x4*)(vp + 768);
                    acc[0] += w0 * v0; acc[1] += pw3 * v0; acc[2] += pw2 * v0; acc[3] += pw1 * v0;
                    acc[0] += w1 * v1; acc[1] += w0 * v1;  acc[2] += pw3 * v1; acc[3] += pw2 * v1;
                    acc[0] += w2 * v2; acc[1] += w1 * v2;  acc[2] += w0 * v2;  acc[3] += pw3 * v2;
                    acc[0] += w3 * v3; acc[1] += w2 * v3;  acc[2] += w1 * v3;  acc[3] += w0 * v3;
                    pw1 = w1; pw2 = w2; pw3 = w3;
                }
                const f32x4 v32 = *(const LAS f32x4*)(vs + (i0 + 32) * 256 + c4), v33 = *(const LAS f32x4*)(vs + (i0 + 33) * 256 + c4);
                acc[2] += pw2 * v32; acc[3] += pw1 * v32; acc[3] += pw2 * v33;
            }
            f32x4 pr[6];
#pragma unroll
            for (int m = 0; m < 6; ++m) {
                const int tq = tb - 2 + m;
                if (tq >= 0) { const bf16_t* uq = U + (size_t)(rb - 2 + m) * DIN; pr[m] = ld_bf4(uq + COL_AC + c4) * ld_bf4(uq + COL_AX + c4); }
                else if (sb >= 0) pr[m] = *(const f32x4*)(a->in[I_SA] + ((size_t)(l * NSB + sb) * 2 + (2 + tq)) * DA + c4);
                else pr[m] = (f32x4){0.f, 0.f, 0.f, 0.f};
            }
            u32x2 abr[4];
#pragma unroll
            for (int j = 0; j < 4; ++j) abr[j] = *(const u32x2*)(ub + (size_t)j * DIN + COL_AB + c4);
            u32x4 ha0[4], ha1[4], bgr[4];
#pragma unroll
            for (int j = 0; j < 4; ++j) { ha0[j] = *(const u32x4*)(HLAC + (size_t)(rb + j) * DB + c8); ha1[j] = *(const u32x4*)(HLAC + (size_t)(rb + j) * DB + c8 + 4);
                bgr[j] = *(const u32x4*)(ub + (size_t)j * DIN + COL_BG + c8); }
            f32x4 ya[4], y0[4], y1[4];
            const f32x4 wa0 = *(const f32x4*)wap, wa1 = *(const f32x4*)(wap + DA), wa2 = *(const f32x4*)(wap + 2 * DA);
#pragma unroll
            for (int j = 0; j < 4; ++j) {
                ya[j] = (f32x4){bflo(abr[j].x), bfhi(abr[j].x), bflo(abr[j].y), bfhi(abr[j].y)} * (wa0 * pr[j] + wa1 * pr[j + 1] + wa2 * pr[j + 2]);
                const f32x4 hl0 = (f32x4){bflo(ha0[j].x), bflo(ha0[j].y), bflo(ha0[j].z), bflo(ha0[j].w)}, hl1 = (f32x4){bflo(ha1[j].x), bflo(ha1[j].y), bflo(ha1[j].z), bflo(ha1[j].w)};
                const f32x4 ac0 = (f32x4){bfhi(ha0[j].x), bfhi(ha0[j].y), bfhi(ha0[j].z), bfhi(ha0[j].w)}, ac1 = (f32x4){bfhi(ha1[j].x), bfhi(ha1[j].y), bfhi(ha1[j].z), bfhi(ha1[j].w)};
                const f32x4 h0 = hl0 + ac0 * *(const LAS f32x4*)(carry + c8), h1 = hl1 + ac1 * *(const LAS f32x4*)(carry + c8 + 4);
                const f32x4 g0 = (f32x4){bflo(bgr[j].x), bfhi(bgr[j].x), bflo(bgr[j].y), bfhi(bgr[j].y)}, g1 = (f32x4){bflo(bgr[j].z), bfhi(bgr[j].z), bflo(bgr[j].w), bfhi(bgr[j].w)};
#pragma unroll
                for (int z = 0; z < 4; ++z) { y0[j][z] = h0[z] * gelu_tanh(g0[z]); y1[j][z] = h1[z] * gelu_tanh(g1[z]); }
                if (islast && i0 + j == len - 1) { *(f32x4*)(o_h + c8) = h0; *(f32x4*)(o_h + c8 + 4) = h1; }
            }
            float sC[4], qC[4], qA[4], qB[4];
#pragma unroll
            for (int j = 0; j < 4; ++j) { sC[j] = hsum4(acc[j]); qC[j] = hsq4(acc[j]); qA[j] = hsq4(ya[j]); qB[j] = hsq4(y0[j]) + hsq4(y1[j]); }
#pragma unroll
            for (int hh = 0; hh < 2; ++hh) {
#pragma unroll
                for (int o = 1; o < 64; o <<= 1) { const int idx = (lane ^ o) << 2;
                    float t1[2], t2[2], t3[2], t4[2];
#pragma unroll
                    for (int j = 0; j < 2; ++j) { const int jj = 2 * hh + j;
                        t1[j] = __builtin_bit_cast(float, __builtin_amdgcn_ds_bpermute(idx, __builtin_bit_cast(int, sC[jj]))); t2[j] = __builtin_bit_cast(float, __builtin_amdgcn_ds_bpermute(idx, __builtin_bit_cast(int, qC[jj])));
                        t3[j] = __builtin_bit_cast(float, __builtin_amdgcn_ds_bpermute(idx, __builtin_bit_cast(int, qA[jj]))); t4[j] = __builtin_bit_cast(float, __builtin_amdgcn_ds_bpermute(idx, __builtin_bit_cast(int, qB[jj]))); }
#pragma unroll
                    for (int j = 0; j < 2; ++j) { const int jj = 2 * hh + j; sC[jj] += t1[j]; qC[jj] += t2[j]; qA[jj] += t3[j]; qB[jj] += t4[j]; } }
            }
            float qY[4];
            const f32x4 lng = *(const f32x4*)lngp, lnb = *(const f32x4*)lnbp;
#pragma unroll
            for (int j = 0; j < 4; ++j) {
                const float mu = sC[j] * (1.0f / DC), var = fmaxf(qC[j] * (1.0f / DC) - mu * mu, 0.f);
                f32x4 y = (acc[j] - mu) * __builtin_amdgcn_rsqf(var + EPS) * lng + lnb;
#pragma unroll
                for (int z = 0; z < 4; ++z) y[z] = y[z] * sigm(y[z]);
                acc[j] = y; qY[j] = hsq4(y);
            }
            wave_sum4_l(qY[0], qY[1], qY[2], qY[3], lane);
            const f32x4 gA = *(const f32x4*)(grp + c4), gC = *(const f32x4*)(grp + 768 + c4), gB0 = *(const f32x4*)(grp + 256 + c8), gB1 = *(const f32x4*)(grp + 256 + c8 + 4);
#pragma unroll
            for (int j = 0; j < 4; ++j) {
                const int i = i0 + j;
                bf16_t* yr = Y + (size_t)(rb + j) * D;
                { const f32x4 y = acc[j] * (__builtin_amdgcn_rsqf(qY[j] * (1.0f / DC) + EPS)) * gC; u32x2 o; o.x = pk2(y[0], y[1]); o.y = pk2(y[2], y[3]); *(u32x2*)(yr + 768 + c4) = o; }
                { const f32x4 y = ya[j] * (__builtin_amdgcn_rsqf(qA[j] * (1.0f / DA) + EPS)) * gA; u32x2 o; o.x = pk2(y[0], y[1]); o.y = pk2(y[2], y[3]); *(u32x2*)(yr + c4) = o; }
                { const float rs = __builtin_amdgcn_rsqf(qB[j] * (1.0f / DB) + EPS); const f32x4 a0 = y0[j] * rs * gB0, a1 = y1[j] * rs * gB1;
                  u32x4 o; o.x = pk2(a0[0], a0[1]); o.y = pk2(a0[2], a0[3]); o.z = pk2(a1[0], a1[1]); o.w = pk2(a1[2], a1[3]); *(u32x4*)(yr + 256 + c8) = o; }
                if (islast) {
                    if (i >= len - 2) *(f32x4*)(o_ca + (size_t)(i - (len - 2)) * DA + c4) = pr[j + 2];
                    if (i >= len - 3) { const bf16_t* ur = ub + (size_t)j * DIN; float* ob = o_cb + (size_t)(i - (len - 3)) * DB + c8; *(f32x4*)ob = ld_bf4(ur + COL_BX + c8); *(f32x4*)(ob + 4) = ld_bf4(ur + COL_BX + c8 + 4); }
                }
            }
        }
        if (islast) {
            for (int e = tid; e < 30 * 64; e += NTHR) { const int i = e >> 6, q = e & 63; *(f32x4*)(o_cc + (size_t)i * DC + 4 * q) = *(const LAS f32x4*)(vs + (len + i) * 256 + 4 * q); }
        }
        LDS_BARRIER();
    }
}

#define XB_TMO      128
#define XB_XCNT(j)  (256  + 64 * (j))
#define XB_XSUB(j)  (1280 + 64 * (j))
#define XB_XGEN(j)  (2304 + 64 * (j))
#define XB_TOP      3328
#define XB_TOPGEN   3392
#define XCD_BAR_WORDS 3456
#define XB_SPIN_CAP (1u << 18)

__device__ __forceinline__ unsigned xb_ld(unsigned* p)              { return __hip_atomic_load(p, __ATOMIC_RELAXED, __HIP_MEMORY_SCOPE_AGENT); }
__device__ __forceinline__ unsigned xb_add(unsigned* p, unsigned v) { return __hip_atomic_fetch_add(p, v, __ATOMIC_RELAXED, __HIP_MEMORY_SCOPE_AGENT); }
__device__ __forceinline__ unsigned xb_xcc_id() { return (unsigned)__builtin_amdgcn_s_getreg((3 << 11) | 20) & 0xFu; }
#define XB_SPIN(cond, bar) do { unsigned _sp = 0; while (cond) { __builtin_amdgcn_s_sleep(1); \
    if ((++_sp & 255u) == 0u) { if (xb_ld(&(bar)[XB_TMO])) break; if (_sp > XB_SPIN_CAP) { atomicAdd(&(bar)[XB_TMO], 1u); break; } } } } while (0)

struct XcdBarrier {
    unsigned* bar; unsigned x;
    volatile LAS unsigned* st;
};

__device__ __forceinline__ XcdBarrier xcd_barrier_post(unsigned* bar, volatile LAS unsigned* st) {
    XcdBarrier b; b.bar = bar; b.x = xb_xcc_id(); b.st = st;
    if (threadIdx.x == 0) (void)xb_add(&bar[XB_XCNT(b.x)], 1u);
    return b;
}
__device__ __forceinline__ void xcd_barrier_complete(unsigned* bar, unsigned x, unsigned& nloc, unsigned& nx) {
    const unsigned G = gridDim.x * gridDim.y * gridDim.z;
    unsigned sum, cnt, mine, sp = 0u;
    for (;;) {
        sum = 0u; cnt = 0u; mine = 0u;
#pragma unroll
        for (unsigned j = 0; j < 16; ++j) { const unsigned c = xb_ld(&bar[XB_XCNT(j)]); sum += c; cnt += (c > 0u) ? 1u : 0u; mine = (j == x) ? c : mine; }
        if (sum == G) break;
        __builtin_amdgcn_s_sleep(1);
        if ((++sp & 255u) == 0u) { if (xb_ld(&bar[XB_TMO])) break; if (sp > XB_SPIN_CAP) { atomicAdd(&bar[XB_TMO], 1u); break; } }
    }
    nloc = mine > 0u ? mine : 1u; nx = cnt > 0u ? cnt : 1u;
}

__device__ __forceinline__ void xcd_barrier(const XcdBarrier& b) {
    asm volatile("s_waitcnt vmcnt(0)" ::: "memory");
    __syncthreads();
    if (threadIdx.x == 0) {
        unsigned* bar = b.bar;
        __builtin_amdgcn_s_waitcnt(0);
        unsigned nloc = b.st[0], nx = b.st[1];
        if (nloc == 0u) { xcd_barrier_complete(bar, b.x, nloc, nx); b.st[0] = nloc; b.st[1] = nx; }
        const unsigned old = xb_add(&bar[XB_XSUB(b.x)], 1u);
        const unsigned gen = old / nloc;
        if (old + 1u == (gen + 1u) * nloc) {
            __builtin_amdgcn_fence(__ATOMIC_RELEASE, "agent");
            asm volatile("s_waitcnt vmcnt(0)" ::: "memory");
            const unsigned og = xb_add(&bar[XB_TOP], 1u);
            const unsigned tg = og / nx;
            if (og + 1u == (tg + 1u) * nx) xb_add(&bar[XB_TOPGEN], 1u);
            else XB_SPIN(xb_ld(&bar[XB_TOPGEN]) == tg, bar);
            __builtin_amdgcn_fence(__ATOMIC_ACQUIRE, "agent");
            xb_add(&bar[XB_XGEN(b.x)], 1u);
            asm volatile("s_waitcnt vmcnt(0)" ::: "memory");
        } else {
            XB_SPIN(xb_ld(&bar[XB_XGEN(b.x)]) == gen, bar);
            __builtin_amdgcn_fence(__ATOMIC_ACQUIRE, "agent");
            asm volatile("s_waitcnt vmcnt(0)" ::: "memory");
        }
    }
    __syncthreads();
}

__global__ void __launch_bounds__(NTHR, 2) fwd_kernel(Args a_val) {
    extern __shared__ __attribute__((aligned(16))) unsigned char lds_raw[];
    LAS unsigned char* lds = (LAS unsigned char*)lds_raw;
    unsigned char* ws = a_val.ws;
    volatile LAS unsigned* bst = (volatile LAS unsigned*)(lds + 131072 + 64);
    if (threadIdx.x < 2) bst[threadIdx.x] = 0u;
    __syncthreads();
    const XcdBarrier bar = xcd_barrier_post((unsigned*)ws, bst);
    const float* mod = (const float*)(ws + WS_MOD);
    const int G = gridDim.x;
    for (int step = a_val.ph_lo; step < a_val.ph_hi; ++step) {
        int ph = step;
#if MK_PROBE == 4
        ph = step == 0 ? 0 : step - 1;
#elif MK_PROBE == 2 || MK_PROBE == 3 || MK_PROBE == 5 || MK_PROBE == 6
        if (step >= 2) {
            constexpr unsigned long long TAB = MK_PROBE == 2 ? 0xA98765443210ull : MK_PROBE == 3 ? 0xA98765543210ull : MK_PROBE == 5 ? 0xA9887654332100ull : 0xA9987665432110ull;
            constexpr int LSTEPS = (MK_PROBE == 2 || MK_PROBE == 3) ? 12 : 14;
            const int ls = (step - 2) / LSTEPS, s = (step - 2) % LSTEPS;
            ph = 2 + 11 * ls + (int)((TAB >> (4 * s)) & 15ull);
        }
#endif
        CArgs a = (CArgs)__builtin_amdgcn_kernarg_segment_ptr(); asm volatile("" : "+s"(a));
        int tid = threadIdx.x; asm volatile("" : "+v"(tid));
        const int lane = tid & 63, wave = __builtin_amdgcn_readfirstlane(tid >> 6);
        if (ph == 0) { if (!MK_NO_PRO) phase_prologue(a, lds, tid, lane, wave); }
        else if (ph == 1) phase_rows(a, lane, wave, 0, false, 0.f, 1, mod, 0, a->in[I_NPOST], mod, 1, 0, a->in[I_NPRE]);
        else {
            const int l = (ph - 2) / 11, k = (ph - 2) % 11;
            const float* modl = mod + (size_t)l * 9 * 9216;
            const bool defer_win = (G == 256) && MK_DEFER_WIN;
            if (k == 0 || k == 8 || k == 1 || k == 9 || k == 6 || k == 3 || (k == 4 && defer_win)) {
                pg8::Gemm g; pg8::EpiMulti E; int N;
                const bool n1024 = (k == 1 || k == 6 || k == 9);
                if (k == 0 || k == 8) {
                    g = pg8::Gemm{(const bf16_t*)(ws + WS_H), (const bf16_t*)(ws + WS_W13 + (size_t)(l * 2 + (k == 0 ? 0 : 1)) * W13_BYTES), MP, 2 * DFF, D, D};
                    E = pg8::EpiMulti{0, (void*)(ws + WS_GU), DFF, nullptr, 8}; N = 2 * DFF;
                } else if (k == 6) {
                    g = pg8::Gemm{(const bf16_t*)(ws + WS_Y), (const bf16_t*)(ws + WS_WOUT + (size_t)l * WOUT_BYTES), MP, D, D, D};
                    E = pg8::EpiMulti{2, (void*)(ws + WS_F), D, (void*)(ws + WS_FPART), 8}; N = D;
                } else if (k == 3 || k == 4) {
                    g = pg8::Gemm{(const bf16_t*)(ws + WS_H), (const bf16_t*)(ws + WS_WIN + (size_t)l * WIN_BYTES), MP, DIN, D, D};
                    E = pg8::EpiMulti{2, (void*)(ws + WS_GU), DIN, nullptr, 8}; N = DIN;
                } else {
                    g = pg8::Gemm{(const bf16_t*)(ws + WS_GU), (const bf16_t*)(ws + WS_W2 + (size_t)(l * 2 + (k == 1 ? 0 : 1)) * W2_BYTES), MP, D, DFF, DFF};
                    E = pg8::EpiMulti{2, (void*)(ws + WS_F), D, (void*)(ws + WS_FPART), 8}; N = D;
                }
                const bool stream_tail = n1024 && (G == 256) && MK_STREAM_TAIL;
                const int nparts = (n1024 && !stream_tail) ? 2 : 1;
                for (int part = 0; part < nparts; ++part) {
                    pg8::StaticOrder S;
                    if (k == 3 && defer_win) { S.init(MP, 7 * 256, G, (int)blockIdx.x); S.mode = 1; }
                    else if (k == 4) { S.init(MP, N, G, (int)blockIdx.x - 176); S.mode = 2; }
                    else if (!n1024) S.init(MP, N, G, (int)blockIdx.x);
                    else if (stream_tail) { S.init(TP, N, G, (int)blockIdx.x, 0, 1, 128); S.mode = 3; S.pmx = TP / 256; S.xsplit = g.ld / 128; E.kshift = 7; }
                    else if (part == 0) S.init(TP, N, G, (int)blockIdx.x);
                    else { S.init(256, N, G, (int)blockIdx.x, TP / 256, g.ld / 256, 256); g.K = 256; E = pg8::EpiMulti{4, (void*)(ws + WS_FPART), D, nullptr, 8}; }
                    if (!MK_NO_G1) pg8::gemm_phase<pg8::EpiMulti, pg8::StaticOrder, true, true>(lds, g, S, E);
                }
            }
            if (k == 4) { if (!MK_NO_MIX1) phase_mix1(a, lds, l, tid, lane, wave, defer_win); }
            else if (k == 0 || k == 8 || k == 1 || k == 9 || k == 6 || k == 3) { }
            else if (k == 5) { if (!MK_NO_MIX2) phase_mix2(a, lds, l, tid, lane, wave); }
            else {
                const int sub = k == 2 ? 0 : (k == 7 ? 1 : 2);
                const bool fin = (k == 10 && l == NL - 1);
                const int ln = k == 10 ? (l + 1 < NL ? l + 1 : l) : l, subn = k == 10 ? 0 : sub + 1;
                phase_rows(a, lane, wave, 1, fin, sub == 1 ? 1.0f : 0.5f, (sub == 1 ? D : DFF) / (((G == 256) && MK_STREAM_TAIL) ? 128 : 256), modl, 3 * sub + 2, a->in[I_NPOST] + (size_t)(l * 3 + sub) * D,
                           mod + (size_t)ln * 9 * 9216, 3 * subn + 1, 3 * subn, a->in[I_NPRE] + (size_t)(ln * 3 + subn) * D);
            }
        }
        if (step + 1 < a_val.ph_hi) xcd_barrier(bar);
#if MK_PROBE == 1
        if (step + 1 < a_val.ph_hi) xcd_barrier(bar);
#endif
        if (a_val.ph_hi == -12345) cg::this_grid().sync();
    }
}

#if MK_CHECK
__device__ __forceinline__ float wsum(float v) { for (int o = 32; o > 0; o >>= 1) v += __shfl_xor(v, o); return v; }
__device__ __forceinline__ float bfv(const bf16_t* p) { return __builtin_bit_cast(float, (unsigned)(*p) << 16); }
__device__ __forceinline__ bool isbad(float got, float ref, float rel, float ab) { const float d = fabsf(got - ref); return !(d <= ab + rel * fabsf(ref)); }
__device__ __forceinline__ void fail(unsigned* w, unsigned code) { atomicMin(w, code); }
__device__ float dotA(const bf16_t* Arow, const float* W, int K, int N, int c, int lane) { float s = 0.f; for (int k = lane; k < K; k += 64) s += bfv(Arow + k) * W[(size_t)k * N + c]; return wsum(s); }
__device__ int chk_row(int i) { const int R[6] = {0, 300, 16383, 16384, 16400, 16511}; return i == 0 ? 0 : i == 1 ? 300 : i == 2 ? 16383 : i == 3 ? 16384 : i == 4 ? 16400 : 16511; }
__global__ void chk_kernel(Args a, int stage) {
    const int lane = threadIdx.x, s = blockIdx.x;
    unsigned char* ws = a.ws; unsigned* word = (unsigned*)(ws + 32768);
    const float* mod = (const float*)(ws + WS_MOD);
    const float* Xb = (const float*)(ws + WS_X); const bf16_t* H = (const bf16_t*)(ws + WS_H); const bf16_t* Fb = (const bf16_t*)(ws + WS_F);
    const bf16_t* GU = (const bf16_t*)(ws + WS_GU); const bf16_t* Y = (const bf16_t*)(ws + WS_Y);
    const int r = chk_row(s % 6), bidx = r < TP ? 0 : 1 + ((r - TP) >> 4);
    const int cs = s / 6;
    if (stage == 1) {
        { const int b = (s * 3) % 9, n = (s * 1531 + 7) % 9216; float acc = 0.f;
          for (int k = lane; k < 1024; k += 64) { const float c = b == 0 ? a.in[I_CP][k] : a.in[I_CS][(b - 1) * 1024 + k]; acc += c / (1.f + expf(-c)) * a.in[I_WADA][(size_t)k * 9216 + n]; }
          acc = wsum(acc) + a.in[I_BADA][n];
          const float got = mod[(size_t)b * 9216 + n], d = fabsf(got - acc);
          if (isbad(got, acc, 1e-3f, 1e-3f)) fail(word, 1); }
        { const int c = (s * 401 + 130) % DFF, row = (c >> 7) * 256 + (c & 127); const bf16_t* WT = (const bf16_t*)(ws + WS_W13);
          for (int k = lane; k < 1024; k += 64) { if (isbad(bfv(WT + (size_t)row * 1024 + k), a.in[I_W1][(size_t)k * DFF + c], 0.01f, 1e-6f)) fail(word, 2);
                                                  if (isbad(bfv(WT + (size_t)(row + 128) * 1024 + k), a.in[I_W3][(size_t)k * DFF + c], 0.01f, 1e-6f)) fail(word, 3); } }
        { const int c = (s * 211 + 513) % D; const bf16_t* WT = (const bf16_t*)(ws + WS_W2);
          for (int k = lane; k < DFF; k += 64) if (isbad(bfv(WT + (size_t)c * DFF + k), a.in[I_W2][(size_t)k * D + c], 0.01f, 1e-6f)) fail(word, 4); }
        { const int c = (s * 577 + 2303) % DIN; const bf16_t* WT = (const bf16_t*)(ws + WS_WIN);
          for (int k = lane; k < D; k += 64) if (isbad(bfv(WT + (size_t)c * D + k), a.in[I_WIN][(size_t)k * DIN + c], 0.01f, 1e-6f)) fail(word, 5); }
        { const int c = (s * 311 + 1023) % D; const bf16_t* WT = (const bf16_t*)(ws + WS_WOUT);
          for (int k = lane; k < D; k += 64) if (isbad(bfv(WT + (size_t)c * D + k), a.in[I_WOUT][(size_t)k * D + c], 0.01f, 1e-6f)) fail(word, 6); }
        { const int c = (s * 401 + 130) % DFF, row = (c >> 7) * 256 + (c & 127); const bf16_t* WT = (const bf16_t*)(ws + WS_W13 + 7 * W13_BYTES);
          for (int k = lane; k < 1024; k += 64) if (isbad(bfv(WT + (size_t)(row + 128) * 1024 + k), a.in[I_W3][(size_t)7 * D * DFF + (size_t)k * DFF + c], 0.01f, 1e-6f)) fail(word, 7); }
    } else if (stage == 2 || stage == 5 || stage == 9) {
        const float* xin = r < TP ? a.in[I_XP] + (size_t)r * D : a.in[I_XS] + (size_t)(r - TP) * D;
        float ssx = 0.f;
        for (int c = lane; c < D; c += 64) ssx += Xb[(size_t)r * D + c] * Xb[(size_t)r * D + c];
        const float rstdx = 1.f / sqrtf(wsum(ssx) / D + EPS);
        if (stage == 2) { for (int c = lane; c < D; c += 64) if (isbad(Xb[(size_t)r * D + c], xin[c], 1e-6f, 1e-6f)) fail(word, 8); }
        if (stage == 5) { float ssf = 0.f; for (int c = lane; c < D; c += 64) { const float f = bfv(Fb + (size_t)r * D + c); ssf += f * f; }
            const float rstdf = 1.f / sqrtf(wsum(ssf) / D + EPS);
            for (int c = lane; c < D; c += 64) { const float ref = xin[c] + 0.5f * mod[((size_t)bidx * 9 + 2) * D + c] * bfv(Fb + (size_t)r * D + c) * rstdf * a.in[I_NPOST][c];
                if (isbad(Xb[(size_t)r * D + c], ref, 1e-3f, 1e-3f)) fail(word, 11); } }
        const int sub = stage == 2 ? 0 : (stage == 5 ? 1 : 2);
        for (int c = lane; c < D; c += 64) { const float ref = Xb[(size_t)r * D + c] * rstdx * a.in[I_NPRE][sub * D + c] * (1.f + mod[((size_t)bidx * 9 + 3 * sub + 1) * D + c]) + mod[((size_t)bidx * 9 + 3 * sub) * D + c];
            if (isbad(bfv(H + (size_t)r * D + c), ref, 0.01f, 0.01f)) fail(word, stage == 2 ? 9 : (stage == 5 ? 12 : 24)); }
    } else if (stage == 3) {
        const int c = (cs * 937 + 130 * (s % 6)) % DFF;
        const float a1 = dotA(H + (size_t)r * D, a.in[I_W1], D, DFF, c, lane), a3 = dotA(H + (size_t)r * D, a.in[I_W3], D, DFF, c, lane);
        const float ref = a1 / (1.f + expf(-a1)) * a3;
        if (isbad(bfv(GU + (size_t)r * DFF + c), ref, 0.03f, 0.03f)) fail(word, 10);
    } else if (stage == 4) {
        const int c = (cs * 341 + 513 * (s % 6)) % D;
        const float ref = dotA(GU + (size_t)r * DFF, a.in[I_W2], DFF, D, c, lane);
        if (isbad(bfv(Fb + (size_t)r * D + c), ref, 0.03f, 0.03f)) fail(word, 13);
    } else if (stage == 6) {
        const int c = (cs * 601 + 255 * (s % 6) + 1) % DIN;
        const float ref = dotA(H + (size_t)r * D, a.in[I_WIN], D, DIN, c, lane);
        if (isbad(bfv(GU + (size_t)r * DIN + c), ref, 0.03f, 0.03f)) fail(word, 14);
    } else if (stage == 8) {
        const int c = (cs * 341 + 513 * (s % 6)) % D;
        const float ref = dotA(Y + (size_t)r * D, a.in[I_WOUT], D, D, c, lane);
        if (isbad(bfv(Fb + (size_t)r * D + c), ref, 0.03f, 0.03f)) fail(word, 23);
    } else if (stage == 7) {
        if (s < 6) {
            const bool smp = s >= 3; const int sbb = s - 3;
            const int rl = smp ? TP + 16 * sbb + 15 : TP - 1;
            for (int c = lane; c < DA; c += 64) { const bf16_t* u = GU + (size_t)rl * DIN; const float ref = bfv(u + COL_AC + c) * bfv(u + COL_AX + c);
                const float got = a.out[(smp ? O_CAS + (size_t)sbb * 2 * DA : O_CAP) + DA + c]; if (isbad(got, ref, 1e-3f, 1e-4f)) fail(word, 15); }
            for (int c = lane; c < DB; c += 64) { const float ref = bfv(GU + (size_t)(rl - 2) * DIN + COL_BX + c);
                const float got = a.out[(smp ? O_CBS + (size_t)sbb * 3 * DB : O_CBP) + c]; if (isbad(got, ref, 1e-3f, 1e-4f)) fail(word, 16); }
            for (int c = lane; c < DC; c += 64) { const bf16_t* u = GU + (size_t)(rl - 3) * DIN; const float ref = bfv(u + COL_CV + c) / (1.f + expf(-bfv(u + COL_CG + c)));
                const float got = a.out[(smp ? O_CCS + (size_t)sbb * 30 * DC : O_CCP) + 26 * DC + c]; if (isbad(got, ref, 2e-3f, 1e-4f)) fail(word, 17); }
            if (smp) { for (int c = lane; c < DC; c += 64) { const float ref = a.in[I_SC][((size_t)sbb * 30 + 20) * DC + c];
                const float got = a.out[O_CCS + (size_t)sbb * 30 * DC + 4 * DC + c]; if (isbad(got, ref, 1e-5f, 1e-6f)) fail(word, 18); } }
        } else if (s < 12) {
            const int which = s - 6; const bool smp = which >= 3; const int sbb = which - 3;
            const int ch = (which * 97 + 5) % DB, head = ch >> 6, ci = 64 * head + lane;
            const int T = smp ? 16 : TP, rbase = smp ? TP + 16 * sbb : 0;
            float h = smp ? a.in[I_SH][(size_t)sbb * DB + ch] : 0.f;
            const float wrl = a.in[I_WGR][((size_t)head * 64 + lane) * 64 + (ch & 63)], wil = a.in[I_WGI][((size_t)head * 64 + lane) * 64 + (ch & 63)];
            const float lam = a.in[I_LAM][ch], lsg = -log1pf(expf(-lam));
            float xm3, xm2, xm1;
            if (smp) { xm3 = a.in[I_SB][((size_t)sbb * 3 + 0) * DB + ci]; xm2 = a.in[I_SB][((size_t)sbb * 3 + 1) * DB + ci]; xm1 = a.in[I_SB][((size_t)sbb * 3 + 2) * DB + ci]; } else { xm3 = xm2 = xm1 = 0.f; }
            const float w0 = a.in[I_WCB][0 * DB + ci], w1 = a.in[I_WCB][1 * DB + ci], w2 = a.in[I_WCB][2 * DB + ci], w3 = a.in[I_WCB][3 * DB + ci], bc = a.in[I_BCB][ci];
            float h100 = 0.f, h63 = 0.f;
            for (int t = 0; t < T; ++t) {
                const float x0 = bfv(GU + (size_t)(rbase + t) * DIN + COL_BX + ci);
                const float xb = bc + w0 * xm3 + w1 * xm2 + w2 * xm1 + w3 * x0; xm3 = xm2; xm2 = xm1; xm1 = x0;
                const float rp = wsum(xb * wrl) + a.in[I_BGR][ch], ip = wsum(xb * wil) + a.in[I_BGI][ch];
                const float xbc = __shfl(xb, ch & 63);
                const float rr = 1.f / (1.f + expf(-rp)), ii = 1.f / (1.f + expf(-ip));
                const float la = 8.f * rr * lsg, av = expf(la);
                h = av * h + sqrtf(-expm1f(2.f * la)) * ii * xbc;
                if (t == 63) h63 = h; if (t == 100) h100 = h;
            }
            const float got = a.out[(smp ? O_HS + (size_t)sbb * DB : O_HP) + ch];
            if (isbad(got, h, 0.02f, 0.003f)) fail(word, smp ? 19 : 20);
            if (!smp) { const float* HL = (const float*)(ws + WS_HL); const float* AC = (const float*)(ws + WS_AC);
                if (isbad(HL[(size_t)63 * DB + ch], h63, 0.01f, 0.002f)) fail(word, 21);
                if (isbad(HL[(size_t)100 * DB + ch] + AC[(size_t)100 * DB + ch] * h63, h100, 0.01f, 0.002f)) fail(word, 22); }
        }
    }
}
__global__ void chk_report(Args a) { const unsigned w = *(unsigned*)(a.ws + 32768); if (w != 0x7f7f7f7fu) a.out[0] = 100.0f * (float)w; }
#endif
}

extern "C" void kernel_launch(void* const* d_in, const int* in_sizes, int n_in, void* d_out, int out_size, void* d_ws, size_t ws_size, hipStream_t stream) {
    using namespace mk;
    static int grid = 0;
    if (grid == 0) {
        if (n_in != 30 || (size_t)out_size != O_END || ws_size < WS_END) { fprintf(stderr, "kernel_launch: unexpected shapes (n_in %d out %d ws %zu)\n", n_in, out_size, ws_size); grid = -1; return; }
        int dev = 0, cus = 0, per_cu = 0;
        if (hipGetDevice(&dev) != hipSuccess || hipDeviceGetAttribute(&cus, hipDeviceAttributeMultiprocessorCount, dev) != hipSuccess) { grid = -1; return; }
        if (hipFuncSetAttribute((const void*)fwd_kernel, hipFuncAttributeMaxDynamicSharedMemorySize, LDS_BYTES) != hipSuccess) { fprintf(stderr, "kernel_launch: hipFuncSetAttribute failed\n"); grid = -1; return; }
        if (hipOccupancyMaxActiveBlocksPerMultiprocessor(&per_cu, (const void*)fwd_kernel, NTHR, LDS_BYTES) != hipSuccess || per_cu < 1) { fprintf(stderr, "kernel_launch: occupancy query gave %d\n", per_cu); per_cu = 1; }
        (void)hipGetLastError();
        grid = cus * 1;
    }
    if (grid < 0) return;
    if (hipMemsetAsync(d_ws, 0, 16384, stream) != hipSuccess) { fprintf(stderr, "kernel_launch: memset failed\n"); return; }
    Args a{};
    for (int i = 0; i < 30; ++i) a.in[i] = (const float*)d_in[i];
    a.out = (float*)d_out; a.ws = (unsigned char*)d_ws;
#if MK_ONE_LAUNCH
    a.ph_lo = 0; a.ph_hi = NSTEP;
    void* args[] = {&a};
    hipError_t e = hipLaunchCooperativeKernel((const void*)fwd_kernel, dim3(grid), dim3(NTHR), args, LDS_BYTES, stream);
    if (e != hipSuccess) fprintf(stderr, "kernel_launch: cooperative launch failed: %s (grid %d)\n", hipGetErrorString(e), grid);
#else
#if MK_CHECK
    hipMemsetAsync((char*)d_ws + 32768, 0x7f, 256, stream);
#endif
    for (int ph = 0; ph < NPH; ++ph) {
        a.ph_lo = ph; a.ph_hi = ph + 1;
        hipLaunchKernelGGL(fwd_kernel, dim3(grid), dim3(NTHR), LDS_BYTES, stream, a);
#if MK_CHECK
        const int stg = ph == 0 ? 1 : ph == 1 ? 2 : ph == 2 ? 3 : ph == 3 ? 4 : ph == 4 ? 5 : ph == 5 ? 6 : ph == 7 ? 7 : ph == 8 ? 8 : ph == 9 ? 9 : 0;
        if (stg) hipLaunchKernelGGL(chk_kernel, dim3(24), dim3(64), 0, stream, a, stg);
#endif
    }
#if MK_CHECK
    hipLaunchKernelGGL(chk_report, dim3(1), dim3(1), 0, stream, a);
#endif
#endif
}
```
